# Optimizing an MI355X kernel written in HIP

```python
import math
import jax
import jax.numpy as jnp
from jax import lax
import numpy as np

D_MODEL = 1024
BATCH = 16
SEQ = 4096
DEPTH = 2
DEC_BATCH = 2
DEC_SEQ = 16384
PAST_LEN = 128

HEAD_DIM = 64
A_Q_HEADS = 8
A_KV_HEADS = 2
A_GROUP = A_Q_HEADS // A_KV_HEADS
A_HALF_WINDOW = 128
B_PAIRS = ((128, 1), (512, 4), (2048, 16))
N_DIL = len(B_PAIRS)
B_HEADS = 4
C_HEADS = 8
GRID_W = 64
NA_KH = 8
NA_KW = 16
D_HEADS = 4
D_HEAD_DIM = 128
D_CHUNK = 64
T5_BUCKETS = 32
T5_MAX_DISTANCE = 1024
T5_HEADS = A_Q_HEADS + N_DIL * B_HEADS
ALPHA = (2.0 * DEPTH) ** 0.25
BETA = (8.0 * DEPTH) ** -0.25
N_EVEN = (DEPTH + 1) // 2
N_ODD = DEPTH // 2
LN_EPS = 1e-5
RMS_EPS = 1e-6

A_Q_W = A_Q_HEADS * HEAD_DIM
A_KV_W = A_KV_HEADS * HEAD_DIM
B_W = B_HEADS * HEAD_DIM
B_QKV_W = N_DIL * B_W
EVEN_SPLITS = (A_Q_W, A_KV_W, A_KV_W, B_QKV_W, B_QKV_W, B_QKV_W, A_Q_W, B_W)
EVEN_IN = sum(EVEN_SPLITS)
EVEN_OUT = A_Q_W + B_W
C_W = C_HEADS * HEAD_DIM
D_W = D_HEADS * D_HEAD_DIM
ODD_SPLITS = (C_W, C_W, C_W, D_W, D_W, D_W, D_W, C_W, D_W)
ODD_IN = sum(ODD_SPLITS)
ODD_OUT = C_W + D_W

kernel_name = "hybrid_bidir_encoder_swa_dilated_na_hgrn2"


def _split(h, sizes):
    return jnp.split(h, [int(c) for c in np.cumsum(sizes)[:-1]], axis=-1)


def t5_buckets(rel):
    nb = T5_BUCKETS // 2
    ret = (rel > 0).astype(np.int64) * nb
    n = np.abs(rel)
    max_exact = nb // 2
    large = max_exact + (np.log(np.maximum(n, 1) / max_exact) / math.log(T5_MAX_DISTANCE / max_exact) * (nb - max_exact)).astype(np.int64)
    large = np.minimum(large, nb - 1)
    return ret + np.where(n < max_exact, n, large)


def layer_norm(x, g, b):
    xf = x.astype(jnp.float32)
    mu = xf.mean(-1, keepdims=True)
    var = jnp.square(xf - mu).mean(-1, keepdims=True)
    return ((xf - mu) * lax.rsqrt(var + LN_EPS) * g.astype(jnp.float32) + b.astype(jnp.float32)).astype(x.dtype)


def banded_attention(q, k, v, bias, sink):
    nb, L, hk, g, hd = q.shape
    W = bias.shape[-2]
    n = -(-L // W)
    pad = n * W - L
    qb = jnp.pad(q, ((0, 0), (0, pad), (0, 0), (0, 0), (0, 0))).reshape(nb, n, W, hk, g, hd)

    def windows(t):
        tp = jnp.pad(t, ((0, 0), (W, pad + W), (0, 0), (0, 0))).reshape(nb, n + 2, W, hk, hd)
        return jnp.concatenate([tp[:, :-2], tp[:, 1:-1], tp[:, 2:]], axis=2)

    kw, vw = windows(k), windows(v)
    qpos = np.arange(n)[:, None, None] * W + np.arange(W)[None, :, None]
    kpos = np.arange(n)[:, None, None] * W + np.arange(3 * W)[None, None, :] - W
    valid = (kpos >= 0) & (kpos < L) & (np.abs(kpos - qpos) <= W)
    s = jnp.einsum('bnqhgd,bnkhd->bnhgqk', qb, kw).astype(jnp.float32) * (hd ** -0.5) + bias
    s = jnp.where(valid[None, :, None, None], s, -jnp.inf)
    m = s.max(-1)
    if sink is not None:
        m = jnp.maximum(m, sink[:, :, None])
    p = jnp.exp(s - m[..., None])
    denom = p.sum(-1)
    if sink is not None:
        denom = denom + jnp.exp(sink[:, :, None] - m)
    o = jnp.einsum('bnhgqk,bnkhd->bnqhgd', p, vw.astype(jnp.float32))
    denom_q = jnp.moveaxis(denom, -1, 2)
    o = (o / denom_q[..., None]).reshape(nb, n * W, hk, g, hd)[:, :L]
    lse = (jnp.moveaxis(m, -1, 2) + jnp.log(denom_q)).reshape(nb, n * W, hk, g)[:, :L]
    return o, lse


def _to_dilated(t, d):
    nb, T = t.shape[:2]
    t = t.reshape(nb, T // d, d, *t.shape[2:])
    return jnp.moveaxis(t, 2, 1).reshape(nb * d, T // d, *t.shape[3:])


def _from_dilated(t, nb, d):
    ld = t.shape[1]
    t = t.reshape(nb, d, ld, *t.shape[2:])
    return jnp.moveaxis(t, 1, 2).reshape(nb, ld * d, *t.shape[3:])


def neighbourhood_attention(q, k, v, rpb):
    nb, T, H, hd = q.shape
    rows = T // GRID_W
    kh = min(NA_KH, rows)
    qg = q.reshape(nb, rows, GRID_W, H, hd)
    kg = k.reshape(nb, rows, GRID_W, H, hd)
    vg = v.reshape(nb, rows, GRID_W, H, hd)
    qc = np.arange(GRID_W)
    sc = np.clip(qc - NA_KW // 2, 0, GRID_W - NA_KW)
    col_mask = (qc[None, :] >= sc[:, None]) & (qc[None, :] < sc[:, None] + NA_KW)
    col_idx = np.clip(qc[None, :] - qc[:, None] + NA_KW - 1, 0, 2 * NA_KW - 2)
    rpb = rpb.astype(jnp.float32)

    def row_block(r):
        sr = jnp.clip(r - kh // 2, 0, rows - kh)
        ks = lax.dynamic_slice_in_dim(kg, sr, kh, axis=1)
        vs = lax.dynamic_slice_in_dim(vg, sr, kh, axis=1)
        qr = lax.dynamic_index_in_dim(qg, r, axis=1, keepdims=False)
        dr = sr + jnp.arange(kh) - r
        bias = jnp.take(rpb, dr + NA_KH - 1, axis=1)[:, :, col_idx]
        s = jnp.einsum('bqhd,bikhd->bhqik', qr, ks).astype(jnp.float32) * (hd ** -0.5) + jnp.transpose(bias, (0, 2, 1, 3))
        s = jnp.where(col_mask[None, None, :, None, :], s, -jnp.inf)
        p = jax.nn.softmax(s.reshape(nb, H, GRID_W, kh * GRID_W), axis=-1).reshape(s.shape)
        return jnp.einsum('bhqik,bikhd->bqhd', p, vs.astype(jnp.float32))

    out = lax.map(row_block, jnp.arange(rows))
    return jnp.moveaxis(out, 0, 1).reshape(nb, T, H, hd)


def gla_chunk_scan(q, k, v, log_f):
    nb, T, H, dk = q.shape
    dv = v.shape[-1]
    C = D_CHUNK
    n = T // C

    def chunks(t):
        return t.reshape(nb, n, C, H, t.shape[-1]).transpose(1, 0, 3, 2, 4)

    b = jnp.cumsum(chunks(log_f), axis=3)
    causal = jnp.tril(jnp.ones((C, C), dtype=bool))

    def step(S, inp):
        qc, kc, vc, bc = inp
        blast = bc[:, :, -1:, :]
        inter = jnp.einsum('bhtk,bhkv->bhtv', qc * jnp.exp(bc), S)
        decay = jnp.exp(jnp.where(causal[:, :, None], bc[:, :, :, None, :] - bc[:, :, None, :, :], -jnp.inf))
        att = jnp.einsum('bhtsk,bhsk->bhts', qc[:, :, :, None, :] * decay, kc)
        o = inter + jnp.einsum('bhts,bhsv->bhtv', att, vc)
        S = jnp.exp(blast[:, :, 0, :, None]) * S + jnp.einsum('bhsk,bhsv->bhkv', kc * jnp.exp(blast - bc), vc)
        return S, o

    S0 = jnp.zeros((nb, H, dk, dv), jnp.float32)
    _, o = lax.scan(step, S0, (chunks(q), chunks(k), chunks(v), b))
    return o.transpose(1, 0, 3, 2, 4).reshape(nb, T, H, dv)


def hgrn2_direction(q, i, z, lb, reverse):
    f = (lb + (1.0 - lb) * jax.nn.sigmoid(z.astype(jnp.float32))).reshape(q.shape)
    k = 1.0 - f
    log_f = jnp.log(f)
    if reverse:
        q, k, i, log_f = (jnp.flip(t, axis=1) for t in (q, k, i, log_f))
    o = gla_chunk_scan(q, k, i, log_f)
    return jnp.flip(o, axis=1) if reverse else o


def even_layer(x, w_in, sink, w_out, t5_table):
    nb, T, _ = x.shape
    qa, ka, va, qb, kb, vb, ga, gb = _split(x @ w_in, EVEN_SPLITS)
    t5 = t5_table.astype(jnp.float32)
    W = A_HALF_WINDOW
    rel_a = np.arange(3 * W)[None, :] - W - np.arange(W)[:, None]
    bias_a = jnp.transpose(t5[:, :A_Q_HEADS][t5_buckets(rel_a)], (2, 0, 1)).reshape(A_KV_HEADS, A_GROUP, W, 3 * W)
    oa, _ = banded_attention(qa.reshape(nb, T, A_KV_HEADS, A_GROUP, HEAD_DIM), ka.reshape(nb, T, A_KV_HEADS, HEAD_DIM),
                             va.reshape(nb, T, A_KV_HEADS, HEAD_DIM), bias_a,
                             sink.astype(jnp.float32).reshape(A_KV_HEADS, A_GROUP))
    oa = oa.reshape(nb, T, A_Q_W)
    qb = qb.reshape(nb, T, N_DIL, B_HEADS, HEAD_DIM)
    kb = kb.reshape(nb, T, N_DIL, B_HEADS, HEAD_DIM)
    vb = vb.reshape(nb, T, N_DIL, B_HEADS, HEAD_DIM)
    outs, lses = [], []
    for g, (win, d) in enumerate(B_PAIRS):
        half = win // (2 * d)
        rel = (np.arange(3 * half)[None, :] - half - np.arange(half)[:, None]) * d
        cols = t5[:, A_Q_HEADS + g * B_HEADS: A_Q_HEADS + (g + 1) * B_HEADS]
        bias = jnp.transpose(cols[t5_buckets(rel)], (2, 0, 1))[:, None]
        o, lse = banded_attention(_to_dilated(qb[:, :, g, :, None, :], d), _to_dilated(kb[:, :, g], d),
                                  _to_dilated(vb[:, :, g], d), bias, None)
        outs.append(_from_dilated(o[:, :, :, 0], nb, d))
        lses.append(_from_dilated(lse[:, :, :, 0], nb, d))
    wts = jax.nn.softmax(jnp.stack(lses), axis=0)
    ob = jnp.einsum('gbth,gbthd->bthd', wts, jnp.stack(outs)).reshape(nb, T, B_W)
    y = jnp.concatenate([oa * jax.nn.silu(ga.astype(jnp.float32)), ob * jax.nn.silu(gb.astype(jnp.float32))], axis=-1)
    return y.astype(x.dtype) @ w_out


def odd_layer(x, w_in, rpb, lb, gnorm, w_out):
    nb, T, _ = x.shape
    qc, kc, vc, qd, idd, zf, zb, gc, gd = _split(x @ w_in, ODD_SPLITS)
    oc = neighbourhood_attention(qc.reshape(nb, T, C_HEADS, HEAD_DIM), kc.reshape(nb, T, C_HEADS, HEAD_DIM),
                                 vc.reshape(nb, T, C_HEADS, HEAD_DIM), rpb).reshape(nb, T, C_W)
    qh = qd.astype(jnp.float32).reshape(nb, T, D_HEADS, D_HEAD_DIM)
    ih = idd.astype(jnp.float32).reshape(nb, T, D_HEADS, D_HEAD_DIM)
    od = hgrn2_direction(qh, ih, zf, lb[0], False) + hgrn2_direction(qh, ih, zb, lb[1], True)
    od = od * lax.rsqrt(jnp.mean(jnp.square(od), axis=-1, keepdims=True) + RMS_EPS)
    od = od.reshape(nb, T, D_W) * gnorm.astype(jnp.float32)
    y = jnp.concatenate([oc * jax.nn.silu(gc.astype(jnp.float32)), od * jax.nn.silu(gd.astype(jnp.float32))], axis=-1)
    return y.astype(x.dtype) @ w_out


def trunk(x, t5_table, w_in_even, sink_a, w_out_even, w_in_odd, rpb_c, lb_d, gnorm_d, w_out_odd, ln_g, ln_b):
    lbs = jnp.cumsum(jax.nn.softmax(lb_d.astype(jnp.float32), axis=1), axis=1)
    lbs = lbs - lbs[:, :1]
    for l in range(DEPTH):
        if l % 2 == 0:
            j = l // 2
            y = even_layer(x, w_in_even[j], sink_a[j], w_out_even[j], t5_table)
        else:
            j = l // 2
            y = odd_layer(x, w_in_odd[j], rpb_c[j], lbs[:, l], gnorm_d[j], w_out_odd[j])
        x = layer_norm(ALPHA * x + y, ln_g[l], ln_b[l])
    return x


def setup_inputs(seed: int = 0) -> dict:
    key = jax.random.key(seed)
    ks = jax.random.split(key, 13)
    nrm = jax.random.normal
    return {
        "x_prompt": nrm(ks[0], (BATCH, SEQ, D_MODEL), jnp.float32),
        "x_sample": nrm(ks[1], (DEC_BATCH, DEC_SEQ, D_MODEL), jnp.float32),
        "t5_table": 0.2 * nrm(ks[2], (T5_BUCKETS, T5_HEADS), jnp.float32),
        "w_in_even": nrm(ks[3], (N_EVEN, D_MODEL, EVEN_IN), jnp.float32) * D_MODEL ** -0.5,
        "sink_a": 0.5 * nrm(ks[4], (N_EVEN, A_Q_HEADS), jnp.float32),
        "w_out_even": nrm(ks[5], (N_EVEN, EVEN_OUT, D_MODEL), jnp.float32) * (EVEN_OUT ** -0.5 * BETA),
        "w_in_odd": nrm(ks[6], (N_ODD, D_MODEL, ODD_IN), jnp.float32) * D_MODEL ** -0.5,
        "rpb_c": 0.2 * nrm(ks[7], (N_ODD, C_HEADS, 2 * NA_KH - 1, 2 * NA_KW - 1), jnp.float32),
        "lb_d": 0.5 * nrm(ks[8], (2, DEPTH, D_W), jnp.float32),
        "gnorm_d": 1.0 + 0.01 * nrm(ks[9], (N_ODD, D_W), jnp.float32),
        "w_out_odd": nrm(ks[10], (N_ODD, ODD_OUT, D_MODEL), jnp.float32) * (ODD_OUT ** -0.5 * BETA),
        "ln_g": 1.0 + 0.01 * nrm(ks[11], (DEPTH, D_MODEL), jnp.float32),
        "ln_b": 0.01 * nrm(ks[12], (DEPTH, D_MODEL), jnp.float32),
    }


def reference(x_prompt, x_sample, t5_table, w_in_even, sink_a, w_out_even, w_in_odd, rpb_c, lb_d, gnorm_d, w_out_odd, ln_g, ln_b):
    y_prompt = trunk(x_prompt, t5_table, w_in_even, sink_a, w_out_even, w_in_odd, rpb_c, lb_d, gnorm_d, w_out_odd, ln_g, ln_b)
    y_sample = trunk(x_sample, t5_table, w_in_even, sink_a, w_out_even, w_in_odd, rpb_c, lb_d, gnorm_d, w_out_odd, ln_g, ln_b)
    return (y_prompt, y_sample)
```

```cpp
#include <hip/hip_runtime.h>
#include <cstdio>
#include <cstdint>
namespace pg8 {
#define PG8_LAS __attribute__((address_space(3)))
typedef unsigned short bf16_t;
typedef short bf16x8 __attribute__((ext_vector_type(8)));
typedef float f32x4 __attribute__((ext_vector_type(4)));
typedef unsigned u32x4 __attribute__((ext_vector_type(4)));
constexpr int BM = 256, BK = 64, HALF = 128, HTB = HALF * BK * 2  , STAGE_BYTES = 8 * HTB, NXCD = 8, WGM = 8;

__host__ __device__ __forceinline__ int lds_byte(int r, int c) { const int st = (r >> 4) * 2 + (c >> 5), rr = r & 15, cc = c & 31, ob = rr * 64 + cc * 2; return st * 1024 + (ob ^ (((ob >> 9) & 1) << 5)); }
__host__ __device__ __forceinline__ void stage_rc(int b, int& R, int& C) { const int st = b / 1024, sb = b % 1024, swz = sb ^ (((sb >> 9) & 1) << 5); R = (st >> 1) * 16 + swz / 64; C = (st & 1) * 32 + (swz % 64) / 2; }
__host__ __device__ __forceinline__ int perm32(int rho) { const int n = rho >> 4, i = rho & 15; return 8 * (i >> 2) + 4 * n + (i & 3); }

struct Unit { int pm, pn; };
struct Gemm { const bf16_t* A; const bf16_t* Bt; int M, N, K; };

struct StaticOrder {
    int nM, nN, nwg, G, c;
    __host__ __device__ void init(int M, int N, int G_, int c_) { nM = M / BM; nN = N / BM; nwg = nM * nN; G = G_; c = c_; }
    __host__ __device__ bool next(int i, Unit& u) const {
        const long L = (long)i * G + c; if (L >= nwg) return false;
        int wgid = (int)L; { const int q = nwg / NXCD, r = nwg % NXCD, xcd = wgid % NXCD, off = wgid / NXCD; wgid = (xcd < r ? xcd * (q + 1) : r * (q + 1) + (xcd - r) * q) + off; }
        const int nig = WGM * nN, gid = wgid / nig, fm = gid * WGM, gsz = (nM - fm) < WGM ? (nM - fm) : WGM;
        u.pm = fm + ((wgid % nig) % gsz); u.pn = (wgid % nig) / gsz; return true;
    }
    __device__ __forceinline__ void a_ready(const Unit&) const {}
    __device__ __forceinline__ void done(const Unit&) const {}
};

__device__ __forceinline__ unsigned cvt_pk_bf16(float lo, float hi) { unsigned r; asm volatile("v_cvt_pk_bf16_f32 %0, %1, %2" : "=v"(r) : "v"(lo), "v"(hi)); return r; }
typedef float f32x2 __attribute__((ext_vector_type(2)));
__device__ __forceinline__ f32x2 gelu_pk(f32x2 v) {
    const f32x2 av = __builtin_elementwise_abs(v), d = av * 0.2316418882f + 1.0f;
    f32x2 t; t.x = __builtin_amdgcn_rcpf(d.x); t.y = __builtin_amdgcn_rcpf(d.y);
    f32x2 q = t * 0.5307027145f + (-0.7265760135f); q = q * t + 0.7107068705f; q = q * t + (-0.142248368f); q = q * t + 0.127414796f; q = q * t;
    const f32x2 s = (v * v) * (-0.72134752044f);
    f32x2 e; e.x = __builtin_amdgcn_exp2f(s.x); e.y = __builtin_amdgcn_exp2f(s.y);
    const f32x2 m = v * (q * e), r = v - m;
    f32x2 o; o.x = v.x < 0.f ? m.x : r.x; o.y = v.y < 0.f ? m.y : r.y; return o;
}

template <int ACT  > struct EpiBf16 {
    static constexpr bool PERM = true, AFTER_DRAIN = false; static_assert(ACT == 0 || ACT == 1, "EpiBf16: ACT is 0 (none) or 1 (gelu_pk)");
    bf16_t* O; int ldc; const float* bias; int split_cols; size_t split_stride; float scale0;
    __device__ __forceinline__ void operator()(const f32x4 (&acc)[2][2][4][2], const Unit& u, int wr, int wc, int fr, int fq) const {
        const int row0 = u.pm * BM + wr * 64 + fr; int colt = u.pn * BM; bf16_t* base = O;
        float sc = 1.f; if (split_cols) { const int t = colt / split_cols; base += (size_t)t * split_stride; colt -= t * split_cols; if (t == 0) sc = scale0; }
        const int col0 = colt + wc * 32 + 8 * fq, bcol0 = u.pn * BM + wc * 32 + 8 * fq;
        f32x4 bv[2][2];
#pragma unroll
        for (int bj = 0; bj < 2; ++bj)
#pragma unroll
            for (int n = 0; n < 2; ++n) bv[bj][n] = bias ? *(const f32x4*)(bias + bcol0 + bj * HALF + 4 * n) : (f32x4){0.f, 0.f, 0.f, 0.f};
#pragma unroll
        for (int ai = 0; ai < 2; ++ai)
#pragma unroll
            for (int m = 0; m < 4; ++m) { bf16_t* rowp = base + (size_t)(row0 + ai * HALF + m * 16) * ldc + col0;
#pragma unroll
                for (int bj = 0; bj < 2; ++bj) { f32x4 v0 = acc[ai][bj][m][0] + bv[bj][0], v1 = acc[ai][bj][m][1] + bv[bj][1];
                    if (ACT == 1) { f32x2 a = gelu_pk((f32x2){v0[0], v0[1]}), b = gelu_pk((f32x2){v0[2], v0[3]}), c = gelu_pk((f32x2){v1[0], v1[1]}), d = gelu_pk((f32x2){v1[2], v1[3]});
                        v0 = (f32x4){a.x, a.y, b.x, b.y}; v1 = (f32x4){c.x, c.y, d.x, d.y}; }
                    v0 = v0 * sc; v1 = v1 * sc; u32x4 w; w.x = cvt_pk_bf16(v0[0], v0[1]); w.y = cvt_pk_bf16(v0[2], v0[3]); w.z = cvt_pk_bf16(v1[0], v1[1]); w.w = cvt_pk_bf16(v1[2], v1[3]);
                    *(u32x4*)(rowp + bj * HALF) = w; } }
    }
};

struct PanelStats {
    unsigned* xbuf;
    unsigned* cnt;
    unsigned* tmo;
    int ntn; float eps;
    unsigned code;
    __device__ __forceinline__ bool run(const f32x4 (&v)[2][2][4][2], const Unit& u, int wr, int wc, int fr, int fq, PG8_LAS unsigned char* lds, int wid, int lane) const {
        typedef float f32x2v __attribute__((ext_vector_type(2)));
        PG8_LAS f32x2v* P = (PG8_LAS f32x2v*)lds;
        PG8_LAS f32x2v* S = (PG8_LAS f32x2v*)(lds + 8192);
        PG8_LAS unsigned* flag = (PG8_LAS unsigned*)(lds + 8192 + 2048);
#pragma unroll
        for (int ai = 0; ai < 2; ++ai)
#pragma unroll
            for (int m = 0; m < 4; ++m) {
                float s = 0.f;
#pragma unroll
                for (int bj = 0; bj < 2; ++bj)
#pragma unroll
                    for (int n = 0; n < 2; ++n) { const f32x4 x = v[ai][bj][m][n]; s += (x[0] + x[1]) + (x[2] + x[3]); }
                s += __shfl_xor(s, 16); s += __shfl_xor(s, 32);
                const float mw = s * (1.0f / 64.0f); float q = 0.f;
#pragma unroll
                for (int bj = 0; bj < 2; ++bj)
#pragma unroll
                    for (int n = 0; n < 2; ++n) { const f32x4 d = v[ai][bj][m][n] - mw; q += (d[0] * d[0] + d[1] * d[1]) + (d[2] * d[2] + d[3] * d[3]); }
                q += __shfl_xor(q, 16); q += __shfl_xor(q, 32);
                if (fq == 0) P[(ai * HALF + wr * 64 + m * 16 + fr) * 4 + wc] = (f32x2v){mw, q};
            }
        asm volatile("s_waitcnt lgkmcnt(0)" ::: "memory"); __builtin_amdgcn_s_barrier(); asm volatile("" ::: "memory");
#if defined(BROKEN_EXCHANGE_NO_WAIT)
#warning BROKEN CONTROL BUILD: the row-statistics exchange does not wait; results are wrong by design
        if (blockIdx.x >= 64) { const long long t0_ = clock64(); while (clock64() - t0_ < 60000) __builtin_amdgcn_s_sleep(8); }
#endif
        const int row = wid * 32 + (lane & 31);
        if (lane < 32) {
            const f32x2v a = P[row * 4 + 0], b = P[row * 4 + 1], c = P[row * 4 + 2], d = P[row * 4 + 3];
            const float mt = (a.x + b.x + c.x + d.x) * 0.25f;
            const float da = a.x - mt, db = b.x - mt, dc = c.x - mt, dd = d.x - mt;
            const float m2 = (a.y + b.y) + (c.y + d.y) + 64.0f * ((da * da + db * db) + (dc * dc + dd * dd));
            unsigned long long* slot = (unsigned long long*)xbuf + ((size_t)(u.pm * BM + row) * 4 + u.pn);
            __hip_atomic_store(slot, ((unsigned long long)__float_as_uint(m2) << 32) | __float_as_uint(mt), __ATOMIC_RELAXED, __HIP_MEMORY_SCOPE_AGENT);
        }
        asm volatile("s_waitcnt vmcnt(0)" ::: "memory");
        if (lane == 0) __hip_atomic_fetch_add(cnt + 64 * u.pm, 1u, __ATOMIC_RELAXED, __HIP_MEMORY_SCOPE_AGENT);
        if (wid == 0) {
            bool dead = false; const unsigned long long t0 = __builtin_amdgcn_s_memrealtime(); const unsigned want = 8u * (unsigned)ntn;
            for (;;) {
#if defined(BROKEN_EXCHANGE_NO_WAIT)
                break;
#endif
                if ((unsigned)__builtin_amdgcn_readfirstlane(__hip_atomic_load(cnt + 64 * u.pm, __ATOMIC_RELAXED, __HIP_MEMORY_SCOPE_AGENT)) >= want) break;
                if (__builtin_amdgcn_s_memrealtime() - t0 > 2000000ull) {
                    if (lane == 0) { unsigned expect = 0u; __hip_atomic_compare_exchange_strong(tmo + 1, &expect, code | (unsigned)(u.pm & 0xff), __ATOMIC_RELAXED, __ATOMIC_RELAXED, __HIP_MEMORY_SCOPE_AGENT);
                                     __hip_atomic_store(tmo, 1u, __ATOMIC_RELAXED, __HIP_MEMORY_SCOPE_AGENT); }
                    dead = true; break; }
                __builtin_amdgcn_s_sleep(2);
            }
            __builtin_amdgcn_fence(__ATOMIC_ACQUIRE, "agent");
            if (lane == 0) flag[0] = dead ? 1u : 0u;
        }
        asm volatile("s_waitcnt vmcnt(0) lgkmcnt(0)" ::: "memory"); __builtin_amdgcn_s_barrier(); asm volatile("" ::: "memory");
        const bool bad = flag[0] != 0u;
        if (lane < 32) {
            const unsigned long long* slot = (const unsigned long long*)xbuf + (size_t)(u.pm * BM + row) * 4; float mt[4], m2[4]; float ms = 0.f;
#pragma unroll
            for (int t = 0; t < 4; ++t) { if (t < ntn) { const unsigned long long w = __hip_atomic_load(slot + t, __ATOMIC_RELAXED, __HIP_MEMORY_SCOPE_AGENT); mt[t] = __uint_as_float((unsigned)w); m2[t] = __uint_as_float((unsigned)(w >> 32)); } else { mt[t] = 0.f; m2[t] = 0.f; } ms += mt[t]; }
            const float mean = ms / (float)ntn; float q = 0.f;
#pragma unroll
            for (int t = 0; t < 4; ++t) if (t < ntn) { const float dm = mt[t] - mean; q += m2[t] + 256.0f * dm * dm; }
            S[row] = (f32x2v){mean, 1.0f / sqrtf(q / (256.0f * (float)ntn) + eps)};
        }
        asm volatile("s_waitcnt lgkmcnt(0)" ::: "memory"); __builtin_amdgcn_s_barrier(); asm volatile("" ::: "memory");
        return bad;
    }
};
struct EpiLnRes {
    static constexpr bool PERM = false, AFTER_DRAIN = true;
    const float* base; float* out; int ldc; const float* bias; PanelStats st; unsigned poison;
    __device__ __forceinline__ void fused(f32x4 (&acc)[2][2][4][2], const Unit& u, int wr, int wc, int fr, int fq, PG8_LAS unsigned char* lds, int wid, int lane) const {
        typedef float f32x2v __attribute__((ext_vector_type(2)));
        const PG8_LAS f32x2v* S = (const PG8_LAS f32x2v*)(lds + 8192);
        const int col0 = u.pn * BM + wc * 32 + 4 * fq;
#pragma unroll
        for (int bj = 0; bj < 2; ++bj)
#pragma unroll
            for (int n = 0; n < 2; ++n) { const f32x4 bv = bias ? *(const f32x4*)(bias + col0 + bj * HALF + n * 16) : (f32x4){0.f, 0.f, 0.f, 0.f};
#pragma unroll
                for (int ai = 0; ai < 2; ++ai)
#pragma unroll
                    for (int m = 0; m < 4; ++m) acc[ai][bj][m][n] += bv; }
        f32x4 pre[4][2][2];
#pragma unroll
        for (int m = 0; m < 4; ++m) { const size_t off = (size_t)(u.pm * BM + wr * 64 + m * 16 + fr) * ldc + col0;
#pragma unroll
            for (int bj = 0; bj < 2; ++bj)
#pragma unroll
                for (int n = 0; n < 2; ++n) pre[m][bj][n] = *(const f32x4*)(base + off + bj * HALF + n * 16); }
        const bool bad = st.run(acc, u, wr, wc, fr, fq, lds, wid, lane) || poison != 0u;
        const float qnan = __builtin_nanf("");
#pragma unroll
        for (int ai = 0; ai < 2; ++ai)
#pragma unroll
            for (int m = 0; m < 4; ++m) { const int r = ai * HALF + wr * 64 + m * 16 + fr; const f32x2v sr = S[r]; const size_t off = (size_t)(u.pm * BM + r) * ldc + col0;
#pragma unroll
                for (int bj = 0; bj < 2; ++bj)
#pragma unroll
                    for (int n = 0; n < 2; ++n) { const f32x4 bs = ai == 0 ? pre[m][bj][n] : *(const f32x4*)(base + off + bj * HALF + n * 16); f32x4 o = bs + (acc[ai][bj][m][n] - sr.x) * sr.y;
                        if (bad) o = (f32x4){qnan, qnan, qnan, qnan}; *(f32x4*)(out + off + bj * HALF + n * 16) = o; }
                if (m & 1) asm volatile("" ::: "memory"); }
    }
};
struct EpiLnResLn {
    static constexpr bool PERM = false, AFTER_DRAIN = true;
    const float* base; float* out; bf16_t* xn; int ldc; const float* bias; PanelStats st1, st2; unsigned poison;
    __device__ __forceinline__ void fused(f32x4 (&acc)[2][2][4][2], const Unit& u, int wr, int wc, int fr, int fq, PG8_LAS unsigned char* lds, int wid, int lane) const {
        typedef float f32x2v __attribute__((ext_vector_type(2))); typedef unsigned u32x2v __attribute__((ext_vector_type(2)));
        const PG8_LAS f32x2v* S = (const PG8_LAS f32x2v*)(lds + 8192);
        const int col0 = u.pn * BM + wc * 32 + 4 * fq;
#pragma unroll
        for (int bj = 0; bj < 2; ++bj)
#pragma unroll
            for (int n = 0; n < 2; ++n) { const f32x4 bv = bias ? *(const f32x4*)(bias + col0 + bj * HALF + n * 16) : (f32x4){0.f, 0.f, 0.f, 0.f};
#pragma unroll
                for (int ai = 0; ai < 2; ++ai)
#pragma unroll
                    for (int m = 0; m < 4; ++m) acc[ai][bj][m][n] += bv; }
        bool bad = st1.run(acc, u, wr, wc, fr, fq, lds, wid, lane) || poison != 0u;
        const float qnan = __builtin_nanf("");
#pragma unroll
        for (int ai = 0; ai < 2; ++ai)
#pragma unroll
            for (int m = 0; m < 4; ++m) { const int r = ai * HALF + wr * 64 + m * 16 + fr; const f32x2v sr = S[r]; const size_t off = (size_t)(u.pm * BM + r) * ldc + col0;
#pragma unroll
                for (int bj = 0; bj < 2; ++bj)
#pragma unroll
                    for (int n = 0; n < 2; ++n) { const f32x4 bs = *(const f32x4*)(base + off + bj * HALF + n * 16); acc[ai][bj][m][n] = bs + (acc[ai][bj][m][n] - sr.x) * sr.y; }
                asm volatile("" : "+v"(acc[ai][0][m][0]), "+v"(acc[ai][0][m][1]), "+v"(acc[ai][1][m][0]), "+v"(acc[ai][1][m][1]));
                if (m & 1) asm volatile("" ::: "memory"); }
        const bool bad1 = bad;
        bad = st2.run(acc, u, wr, wc, fr, fq, lds, wid, lane) || bad;
#pragma unroll
        for (int ai = 0; ai < 2; ++ai)
#pragma unroll
            for (int m = 0; m < 4; ++m) { const int r = ai * HALF + wr * 64 + m * 16 + fr; const f32x2v sr = S[r]; const size_t off = (size_t)(u.pm * BM + r) * ldc + col0;
#pragma unroll
                for (int bj = 0; bj < 2; ++bj)
#pragma unroll
                    for (int n = 0; n < 2; ++n) { const f32x4 x1 = acc[ai][bj][m][n]; *(f32x4*)(out + off + bj * HALF + n * 16) = bad1 ? (f32x4){qnan, qnan, qnan, qnan} : x1;
                        const f32x4 o = (x1 - sr.x) * sr.y; u32x2v w; w.x = cvt_pk_bf16(o[0], o[1]); w.y = cvt_pk_bf16(o[2], o[3]);
                        if (bad) { w.x = 0x7fc07fc0u; w.y = 0x7fc07fc0u; } *(u32x2v*)(xn + off + bj * HALF + n * 16) = w; }
                asm volatile("" ::: "memory"); }
    }
};

template <class Epi, class Sched, bool ALIGN_EPI = false, bool SP2 = false>
__device__ __forceinline__ void gemm_phase(PG8_LAS unsigned char* lds, const Gemm g, const Sched& S, const Epi& E) {
    int tid_ = threadIdx.x; asm volatile("" : "+v"(tid_));
    const int tid = tid_, wid = __builtin_amdgcn_readfirstlane(tid >> 6), lane = tid & 63, wr = wid >> 2, wc = wid & 3, fr = lane & 15, fq = lane >> 4;
    const int K = g.K, nt = K / BK;
    unsigned voffA[2], voffB[2];
#pragma unroll
    for (int i = 0; i < 2; ++i) { int R, C; stage_rc(tid * 16 + i * 8192, R, C); const int Rb = Epi::PERM ? ((R & ~31) + perm32(R & 31)) : R;
        voffA[i] = (unsigned)(R * K + C) * 2u; voffB[i] = (unsigned)(Rb * K + C) * 2u; }
    const size_t kstep = (size_t)(BK * 2);
    const size_t hstep = (size_t)HALF * K * 2;
    const size_t tstep = 2 * hstep;
    const unsigned ldsw = (unsigned)wid * 1024u;
    const int aoff = lds_byte(wr * 64 + fr, fq * 8), boff = lds_byte(wc * 32 + fr, fq * 8);
#define PG8_SA(b, h) (((b) * 2 + (h)) * HTB)
#define PG8_SB(b, h) ((4 + (b) * 2 + (h)) * HTB)
#define PG8_STAGE(bufoff, gbase, voff) do { _Pragma("unroll") for (int _i = 0; _i < 2; ++_i) \
        __builtin_amdgcn_global_load_lds((const unsigned*)((const char*)(gbase) + (voff)[_i]), (PG8_LAS unsigned*)(lds + (bufoff) + ldsw + _i * 8192), 16, 0, 0); } while (0)
#define PG8_LDA(dst, b, h) do { _Pragma("unroll") for (int m = 0; m < 4; ++m) _Pragma("unroll") for (int k = 0; k < 2; ++k) dst[m][k] = *(const PG8_LAS bf16x8*)(lds + PG8_SA(b, h) + aoff + m * 2048 + k * 1024); } while (0)
#define PG8_LDB(dst, b, h) do { _Pragma("unroll") for (int n = 0; n < 2; ++n) _Pragma("unroll") for (int k = 0; k < 2; ++k) dst[n][k] = *(const PG8_LAS bf16x8*)(lds + PG8_SB(b, h) + boff + n * 2048 + k * 1024); } while (0)
#define PG8_MMA(ai, bj, At, Bt) do { __builtin_amdgcn_s_setprio(1); _Pragma("unroll") for (int m = 0; m < 4; ++m) _Pragma("unroll") for (int n = 0; n < 2; ++n) _Pragma("unroll") for (int k = 0; k < 2; ++k) \
        acc[ai][bj][m][n] = __builtin_amdgcn_mfma_f32_16x16x32_bf16(Bt[n][k], At[m][k], acc[ai][bj][m][n], 0, 0, 0); __builtin_amdgcn_s_setprio(0); } while (0)
#define PG8_WAIT_V(n) asm volatile("s_waitcnt vmcnt(" #n ")" ::: "memory")
#define PG8_WAIT_L(n) asm volatile("s_waitcnt lgkmcnt(" #n ")" ::: "memory")
#define PG8_BAR __builtin_amdgcn_s_barrier()
#define PG8_SCHED __builtin_amdgcn_sched_barrier(0)
    Unit cur, nxt; int ui = 0;
    if (!S.next(0, cur)) return;
    f32x4 acc[2][2][4][2];
#pragma unroll
    for (int a = 0; a < 2; ++a)
#pragma unroll
        for (int b = 0; b < 2; ++b)
#pragma unroll
            for (int m = 0; m < 4; ++m)
#pragma unroll
                for (int n = 0; n < 2; ++n) acc[a][b][m][n] = (f32x4){0.f, 0.f, 0.f, 0.f};
    bf16x8 At[4][2], B0[2][2], B1[2][2];
    const char* cA = (const char*)g.A + (size_t)cur.pm * tstep; const char* cB = (const char*)g.Bt + (size_t)cur.pn * tstep;
    S.a_ready(cur);
    if constexpr (SP2) {
        PG8_STAGE(PG8_SB(0, 0), cB, voffB); PG8_STAGE(PG8_SB(0, 1), cB + hstep, voffB); PG8_STAGE(PG8_SA(0, 0), cA, voffA); PG8_STAGE(PG8_SA(0, 1), cA + hstep, voffA);
        if (wr == 1) PG8_BAR;
        PG8_WAIT_V(2); PG8_BAR;
        PG8_STAGE(PG8_SB(1, 0), cB + kstep, voffB); PG8_STAGE(PG8_SA(1, 0), cA + kstep, voffA); PG8_STAGE(PG8_SB(1, 1), cB + hstep + kstep, voffB);
        PG8_WAIT_V(6); PG8_BAR;
    } else {
        PG8_STAGE(PG8_SB(0, 0), cB, voffB); PG8_STAGE(PG8_SA(0, 0), cA, voffA); PG8_STAGE(PG8_SB(0, 1), cB + hstep, voffB); PG8_STAGE(PG8_SA(0, 1), cA + hstep, voffA);
        if (wr == 1) PG8_BAR;
        PG8_WAIT_V(4); PG8_BAR;
        PG8_STAGE(PG8_SB(1, 0), cB + kstep, voffB); PG8_STAGE(PG8_SA(1, 0), cA + kstep, voffA); PG8_STAGE(PG8_SB(1, 1), cB + hstep + kstep, voffB);
        PG8_WAIT_V(6); PG8_BAR;
    }
    for (;;) {
        const bool has_next = S.next(ui + 1, nxt);
        const char* nA = has_next ? (const char*)g.A + (size_t)nxt.pm * tstep : cA; const char* nB = has_next ? (const char*)g.Bt + (size_t)nxt.pn * tstep : cB;
        for (int t = 0; t < nt; t += 2) {
            const bool last = (t == nt - 2);
            const char* a1 = cA + (size_t)(t + 1) * kstep;
            const char* a2 = last ? nA : cA + (size_t)(t + 2) * kstep; const char* b2 = last ? nB : cB + (size_t)(t + 2) * kstep;
            const char* a3 = a2 + kstep; const char* b3 = b2 + kstep;
            if (last && has_next) S.a_ready(nxt);
            if constexpr (SP2) {
            PG8_LDB(B0, 0, 0); PG8_LDB(B1, 0, 1); PG8_SCHED; PG8_LDA(At, 0, 0); PG8_STAGE(PG8_SA(1, 1), a1 + hstep, voffA);
            PG8_WAIT_V(8); PG8_WAIT_L(0); PG8_BAR; PG8_MMA(0, 0, At, B0); PG8_MMA(0, 1, At, B1); PG8_BAR; PG8_SCHED;
            PG8_LDA(At, 0, 1); PG8_STAGE(PG8_SB(0, 0), b2, voffB); PG8_STAGE(PG8_SB(0, 1), b2 + hstep, voffB); PG8_STAGE(PG8_SA(0, 0), a2, voffA);
            PG8_WAIT_V(8); PG8_WAIT_L(0); PG8_BAR; PG8_MMA(1, 0, At, B0); PG8_MMA(1, 1, At, B1); PG8_BAR; PG8_SCHED;
            PG8_LDB(B0, 1, 0); PG8_LDB(B1, 1, 1); PG8_SCHED; PG8_LDA(At, 1, 0); PG8_STAGE(PG8_SA(0, 1), a2 + hstep, voffA);
            PG8_WAIT_V(8); PG8_WAIT_L(0); PG8_BAR; PG8_MMA(0, 0, At, B0); PG8_MMA(0, 1, At, B1); PG8_BAR; PG8_SCHED;
            PG8_LDA(At, 1, 1); PG8_STAGE(PG8_SB(1, 0), b3, voffB); PG8_STAGE(PG8_SB(1, 1), b3 + hstep, voffB); PG8_STAGE(PG8_SA(1, 0), a3, voffA);
            PG8_WAIT_V(8); PG8_WAIT_L(0); PG8_BAR; PG8_MMA(1, 0, At, B0); PG8_MMA(1, 1, At, B1); PG8_BAR; PG8_SCHED;
            } else {
            PG8_LDB(B0, 0, 0); PG8_SCHED; PG8_LDA(At, 0, 0); PG8_STAGE(PG8_SA(1, 1), a1 + hstep, voffA);
            PG8_WAIT_L(8); PG8_BAR; PG8_WAIT_L(0); PG8_MMA(0, 0, At, B0); PG8_BAR; PG8_SCHED;
            PG8_LDB(B1, 0, 1); PG8_STAGE(PG8_SB(0, 0), b2, voffB);
            PG8_BAR; PG8_WAIT_L(0); PG8_MMA(0, 1, At, B1); PG8_BAR;
            PG8_LDA(At, 0, 1); PG8_STAGE(PG8_SA(0, 0), a2, voffA);
            PG8_BAR; PG8_WAIT_L(0); PG8_MMA(1, 0, At, B0); PG8_BAR; PG8_SCHED;
            PG8_STAGE(PG8_SB(0, 1), b2 + hstep, voffB);
            PG8_WAIT_V(6); PG8_BAR; PG8_MMA(1, 1, At, B1); PG8_BAR;
            PG8_LDB(B0, 1, 0); PG8_SCHED; PG8_LDA(At, 1, 0); PG8_STAGE(PG8_SA(0, 1), a2 + hstep, voffA);
            PG8_WAIT_L(8); PG8_BAR; PG8_WAIT_L(0); PG8_MMA(0, 0, At, B0); PG8_BAR; PG8_SCHED;
            PG8_LDB(B1, 1, 1); PG8_STAGE(PG8_SB(1, 0), b3, voffB);
            PG8_BAR; PG8_WAIT_L(0); PG8_MMA(0, 1, At, B1); PG8_BAR;
            PG8_LDA(At, 1, 1); PG8_STAGE(PG8_SA(1, 0), a3, voffA);
            PG8_BAR; PG8_WAIT_L(0); PG8_MMA(1, 0, At, B0); PG8_BAR; PG8_SCHED;
            PG8_STAGE(PG8_SB(1, 1), b3 + hstep, voffB);
            PG8_WAIT_V(6); PG8_BAR; PG8_MMA(1, 1, At, B1); PG8_BAR;
            }
        }
        if constexpr (ALIGN_EPI) { if (wr == 0) PG8_BAR; }
        if constexpr (!Epi::AFTER_DRAIN) { E(acc, cur, wr, wc, fr, fq); S.done(cur); }
        if (!has_next) break;
#pragma unroll
        for (int a = 0; a < 2; ++a)
#pragma unroll
            for (int b = 0; b < 2; ++b)
#pragma unroll
                for (int m = 0; m < 4; ++m)
#pragma unroll
                    for (int n = 0; n < 2; ++n) acc[a][b][m][n] = (f32x4){0.f, 0.f, 0.f, 0.f};
        cur = nxt; cA = nA; cB = nB; ++ui;
        if constexpr (ALIGN_EPI) { if (wr == 1) PG8_BAR; }
    }
    PG8_WAIT_V(0);
    if constexpr (!ALIGN_EPI) { if (wr == 0) PG8_BAR; }
    PG8_BAR;
    if constexpr (Epi::AFTER_DRAIN) { E.fused(acc, cur, wr, wc, fr, fq, lds, wid, lane); S.done(cur); }
#undef PG8_SA
#undef PG8_SB
#undef PG8_STAGE
#undef PG8_LDA
#undef PG8_LDB
#undef PG8_MMA
#undef PG8_WAIT_V
#undef PG8_WAIT_L
#undef PG8_BAR
#undef PG8_SCHED
}
}
#define GAS __attribute__((address_space(1)))
#define LAS __attribute__((address_space(3)))
typedef unsigned short bf16;
typedef unsigned v4u __attribute__((ext_vector_type(4)));
typedef float f32x4 __attribute__((ext_vector_type(4)));
typedef short bf16x8 __attribute__((ext_vector_type(8)));
typedef GAS unsigned gu32;
typedef GAS unsigned long long gu64;
#define RLX_AGENT __ATOMIC_RELAXED, __HIP_MEMORY_SCOPE_AGENT
#define LDS_WAIT() asm volatile("s_waitcnt lgkmcnt(0)" ::: "memory")
#define VM_WAIT() asm volatile("s_waitcnt vmcnt(0)" ::: "memory")
__device__ __forceinline__ unsigned long long rt() { return __builtin_amdgcn_s_memrealtime(); }
__device__ __forceinline__ unsigned f2bf(float f) { unsigned u = __builtin_bit_cast(unsigned, f); return (u + 0x7fffu + ((u >> 16) & 1u)) >> 16; }
__device__ __forceinline__ unsigned pk2(float lo, float hi) { return f2bf(lo) | (f2bf(hi) << 16); }

#define XB_TMO      128
#define XB_XCNT(j)  (256  + 64 * (j))
#define XB_XSUB(j)  (1280 + 64 * (j))
#define XB_XGEN(j)  (2304 + 64 * (j))
#define XB_TOP      3328
#define XB_TOPGEN   3392
#define XCD_BAR_WORDS 3456
#define XB_SPIN_CAP (1u << 18)

__device__ __forceinline__ unsigned xb_ld(unsigned* p)              { return __hip_atomic_load(p, __ATOMIC_RELAXED, __HIP_MEMORY_SCOPE_AGENT); }
__device__ __forceinline__ unsigned xb_add(unsigned* p, unsigned v) { return __hip_atomic_fetch_add(p, v, __ATOMIC_RELAXED, __HIP_MEMORY_SCOPE_AGENT); }
__device__ __forceinline__ unsigned xb_xcc_id() { return (unsigned)__builtin_amdgcn_s_getreg((3 << 11) | 20) & 0xFu; }
#define XB_SPIN(cond, bar) do { unsigned _sp = 0; while (cond) { __builtin_amdgcn_s_sleep(1); \
    if ((++_sp & 255u) == 0u) { if (xb_ld(&(bar)[XB_TMO])) break; if (_sp > XB_SPIN_CAP) { atomicAdd(&(bar)[XB_TMO], 1u); break; } } } } while (0)

struct XcdBarrier {
    unsigned* bar; unsigned x;
    volatile LAS unsigned* st;
};

__device__ __forceinline__ XcdBarrier xcd_barrier_post(unsigned* bar, volatile LAS unsigned* st) {
    XcdBarrier b; b.bar = bar; b.x = xb_xcc_id(); b.st = st;
    if (threadIdx.x == 0) (void)xb_add(&bar[XB_XCNT(b.x)], 1u);
    return b;
}
__device__ __forceinline__ void xcd_barrier_complete(unsigned* bar, unsigned x, unsigned& nloc, unsigned& nx) {
    const unsigned G = gridDim.x * gridDim.y * gridDim.z;
    unsigned sum, cnt, mine, sp = 0u;
    for (;;) {
        sum = 0u; cnt = 0u; mine = 0u;
#pragma unroll
        for (unsigned j = 0; j < 16; ++j) { const unsigned c = xb_ld(&bar[XB_XCNT(j)]); sum += c; cnt += (c > 0u) ? 1u : 0u; mine = (j == x) ? c : mine; }
        if (sum == G) break;
        __builtin_amdgcn_s_sleep(1);
        if ((++sp & 255u) == 0u) { if (xb_ld(&bar[XB_TMO])) break; if (sp > XB_SPIN_CAP) { atomicAdd(&bar[XB_TMO], 1u); break; } }
    }
    nloc = mine > 0u ? mine : 1u; nx = cnt > 0u ? cnt : 1u;
}

__device__ __forceinline__ void xcd_barrier(const XcdBarrier& b) {
    asm volatile("s_waitcnt vmcnt(0)" ::: "memory");
    __syncthreads();
    if (threadIdx.x == 0) {
        unsigned* bar = b.bar;
        __builtin_amdgcn_s_waitcnt(0);
        unsigned nloc = b.st[0], nx = b.st[1];
        if (nloc == 0u) { xcd_barrier_complete(bar, b.x, nloc, nx); b.st[0] = nloc; b.st[1] = nx; }
        const unsigned old = xb_add(&bar[XB_XSUB(b.x)], 1u);
        const unsigned gen = old / nloc;
        if (old + 1u == (gen + 1u) * nloc) {
            __builtin_amdgcn_fence(__ATOMIC_RELEASE, "agent");
            asm volatile("s_waitcnt vmcnt(0)" ::: "memory");
            const unsigned og = xb_add(&bar[XB_TOP], 1u);
            const unsigned tg = og / nx;
            if (og + 1u == (tg + 1u) * nx) xb_add(&bar[XB_TOPGEN], 1u);
            else XB_SPIN(xb_ld(&bar[XB_TOPGEN]) == tg, bar);
            __builtin_amdgcn_fence(__ATOMIC_ACQUIRE, "agent");
            xb_add(&bar[XB_XGEN(b.x)], 1u);
            asm volatile("s_waitcnt vmcnt(0)" ::: "memory");
        } else {
            XB_SPIN(xb_ld(&bar[XB_XGEN(b.x)]) == gen, bar);
            __builtin_amdgcn_fence(__ATOMIC_ACQUIRE, "agent");
            asm volatile("s_waitcnt vmcnt(0)" ::: "memory");
        }
    }
    __syncthreads();
}

constexpr int NWAVES = 8;
constexpr int DM = 1024;
constexpr int NP_TOK = 16 * 4096, NS_TOK = 2 * 16384, NTOK = NP_TOK + NS_TOK;
constexpr int T_P = 4096, T_S = 16384;
constexpr int MC = 32768, NCH = NTOK / MC;
constexpr int EVEN_IN = 3840, EVEN_OUT = 768, ODD_IN = 4608, ODD_OUT = 1024;
constexpr float ALPHA = 1.4142135623730951f;
constexpr float LN_EPS = 1e-5f, RMS_EPS = 1e-6f;

constexpr size_t MiB = 1u << 20;
constexpr size_t WS_CTL = 0, CTL_ZERO_BYTES = 1 * MiB;
constexpr size_t WS_W1 = 2 * MiB;
constexpr size_t WS_W2 = 10 * MiB;
constexpr size_t WS_W3 = 12 * MiB;
constexpr size_t WS_W4 = 22 * MiB;
constexpr size_t WS_XB = 32 * MiB;
constexpr size_t WS_H  = 96 * MiB;
constexpr size_t WS_Y  = 384 * MiB;
constexpr size_t WS_Z  = 448 * MiB;
constexpr size_t WS_O  = 576 * MiB;
constexpr size_t WS_END = 704 * MiB;
constexpr int CW_BAR = 4096;

constexpr int RING_BYTES = 131072;
constexpr int LDSCTL_OFF = RING_BYTES, MISC_OFF = LDSCTL_OFF + 320;
constexpr int LDS_BYTES = 147456;

__device__ __forceinline__ float bf2f(unsigned short b) { return __builtin_bit_cast(float, (unsigned)b << 16); }
__device__ __forceinline__ float bflo(unsigned u) { return __builtin_bit_cast(float, u << 16); }
__device__ __forceinline__ float bfhi(unsigned u) { return __builtin_bit_cast(float, u & 0xffff0000u); }
__device__ __forceinline__ float sigmoidf_(float x) { return 1.f / (1.f + __expf(-x)); }
__device__ __forceinline__ float siluf_(float x) { return x / (1.f + __expf(-x)); }

__device__ __forceinline__ int t5_bucket(int rel) {
    const int n = rel < 0 ? -rel : rel;
    int b = n < 8 ? n : n < 15 ? 8 : n < 27 ? 9 : n < 50 ? 10 : n < 91 ? 11 : n < 166 ? 12 : n < 305 ? 13 : n < 559 ? 14 : 15;
    return b + (rel > 0 ? 16 : 0);
}

__device__ __forceinline__ float wave_sum(float v) {
#pragma unroll
    for (int o = 1; o < 64; o <<= 1) v += __shfl_xor(v, o);
    return v;
}

__device__ __forceinline__ void p0_transpose_item(const float* W, int K, int N, bf16* WT, LAS float* scr, int item, int lane) {
    const int nblk = N / 32, kb = item / nblk, nb = item % nblk, k0 = 64 * kb, n0 = 32 * nb;
#pragma unroll 8
    for (int i = 0; i < 32; ++i) { const int kk = 2 * i + (lane >> 5); scr[kk * 33 + (lane & 31)] = W[(size_t)(k0 + kk) * N + n0 + (lane & 31)]; }
    LDS_WAIT(); asm volatile("" ::: "memory");
    const int c = lane & 7;
#pragma unroll
    for (int j = 0; j < 4; ++j) { const int n = (lane >> 3) + 8 * j; const LAS float* s = scr + (8 * c) * 33 + n;
        v4u o; o.x = pk2(s[0 * 33], s[1 * 33]); o.y = pk2(s[2 * 33], s[3 * 33]); o.z = pk2(s[4 * 33], s[5 * 33]); o.w = pk2(s[6 * 33], s[7 * 33]);
        *(GAS v4u*)(WT + (size_t)(n0 + n) * K + k0 + 8 * c) = o; }
    LDS_WAIT(); asm volatile("" ::: "memory");
}

struct EpiResF32 {
    static constexpr bool PERM = false, AFTER_DRAIN = false;
    const float* base; float* out; int ldc; float alpha;
    __device__ __forceinline__ void operator()(const pg8::f32x4 (&acc)[2][2][4][2], const pg8::Unit& u, int wr, int wc, int fr, int fq) const {
        const int col0 = u.pn * pg8::BM + wc * 32 + 4 * fq;
#pragma unroll
        for (int ai = 0; ai < 2; ++ai)
#pragma unroll
            for (int m = 0; m < 4; ++m) { const size_t off = (size_t)(u.pm * pg8::BM + ai * pg8::HALF + wr * 64 + m * 16 + fr) * ldc + col0;
#pragma unroll
                for (int bj = 0; bj < 2; ++bj)
#pragma unroll
                    for (int n = 0; n < 2; ++n) { const pg8::f32x4 bs = *(const pg8::f32x4*)(base + off + bj * pg8::HALF + n * 16);
                        *(pg8::f32x4*)(out + off + bj * pg8::HALF + n * 16) = bs * alpha + acc[ai][bj][m][n]; }
                asm volatile("" ::: "memory"); }
    }
};

__device__ __forceinline__ void load_row64(const bf16* p, float (&x)[64], float scale) {
#pragma unroll
    for (int c = 0; c < 8; ++c) { const v4u w = *(const GAS v4u*)(p + c * 8);
        x[c * 8 + 0] = bflo(w.x) * scale; x[c * 8 + 1] = bfhi(w.x) * scale; x[c * 8 + 2] = bflo(w.y) * scale; x[c * 8 + 3] = bfhi(w.y) * scale;
        x[c * 8 + 4] = bflo(w.z) * scale; x[c * 8 + 5] = bfhi(w.z) * scale; x[c * 8 + 6] = bflo(w.w) * scale; x[c * 8 + 7] = bfhi(w.w) * scale; }
}
__device__ __forceinline__ void attend(const bf16* krow, const bf16* vrow, const float (&q)[64], float bias, float& m, float& l, float (&o)[64]) {
    float dot = 0.f;
#pragma unroll
    for (int c = 0; c < 8; ++c) { const v4u w = *(const GAS v4u*)(krow + c * 8);
        dot += q[c * 8 + 0] * bflo(w.x) + q[c * 8 + 1] * bfhi(w.x) + q[c * 8 + 2] * bflo(w.y) + q[c * 8 + 3] * bfhi(w.y)
             + q[c * 8 + 4] * bflo(w.z) + q[c * 8 + 5] * bfhi(w.z) + q[c * 8 + 6] * bflo(w.w) + q[c * 8 + 7] * bfhi(w.w); }
    const float s = dot + bias, mn = fmaxf(m, s), a = __expf(m - mn), p = __expf(s - mn);
    l = l * a + p; m = mn;
#pragma unroll
    for (int c = 0; c < 8; ++c) { const v4u w = *(const GAS v4u*)(vrow + c * 8);
        o[c * 8 + 0] = o[c * 8 + 0] * a + p * bflo(w.x); o[c * 8 + 1] = o[c * 8 + 1] * a + p * bfhi(w.x);
        o[c * 8 + 2] = o[c * 8 + 2] * a + p * bflo(w.y); o[c * 8 + 3] = o[c * 8 + 3] * a + p * bfhi(w.y);
        o[c * 8 + 4] = o[c * 8 + 4] * a + p * bflo(w.z); o[c * 8 + 5] = o[c * 8 + 5] * a + p * bfhi(w.z);
        o[c * 8 + 6] = o[c * 8 + 6] * a + p * bflo(w.w); o[c * 8 + 7] = o[c * 8 + 7] * a + p * bfhi(w.w); }
}
__device__ __forceinline__ void gate_store64(const float (&o)[64], float l, const bf16* gate, bf16* y) {
    const float rl = 1.f / l;
#pragma unroll
    for (int c = 0; c < 8; ++c) { const v4u g = *(const GAS v4u*)(gate + c * 8); v4u w;
        w.x = pk2(o[c * 8 + 0] * rl * siluf_(bflo(g.x)), o[c * 8 + 1] * rl * siluf_(bfhi(g.x)));
        w.y = pk2(o[c * 8 + 2] * rl * siluf_(bflo(g.y)), o[c * 8 + 3] * rl * siluf_(bfhi(g.y)));
        w.z = pk2(o[c * 8 + 4] * rl * siluf_(bflo(g.z)), o[c * 8 + 5] * rl * siluf_(bfhi(g.z)));
        w.w = pk2(o[c * 8 + 6] * rl * siluf_(bflo(g.w)), o[c * 8 + 7] * rl * siluf_(bfhi(g.w)));
        *(GAS v4u*)(y + c * 8) = w; }
}

__device__ __forceinline__ void naive_even(const bf16* H, bf16* Y, int T, const float* t5, const float* sink, int gtid, int gstride) {
    for (int it = gtid; it < MC * 12; it += gstride) {
        const int hh = it / MC, tok = it - hh * MC, pos = tok % T, sb = tok - pos;
        float q[64], o[64], m, l;
#pragma unroll
        for (int d = 0; d < 64; ++d) o[d] = 0.f;
        const bf16* hrow = H + (size_t)tok * EVEN_IN;
        if (hh < 8) {
            load_row64(hrow + hh * 64, q, 0.125f);
            m = sink[hh]; l = 1.f;
            const int kvh = hh >> 2;
            for (int rel = -128; rel <= 128; ++rel) { const int kp = pos + rel; if (kp < 0 || kp >= T) continue;
                const bf16* kr = H + (size_t)(sb + kp) * EVEN_IN;
                attend(kr + 512 + kvh * 64, kr + 640 + kvh * 64, q, t5[t5_bucket(rel) * 20 + hh], m, l, o); }
            gate_store64(o, l, hrow + 3072 + hh * 64, Y + (size_t)tok * EVEN_OUT + hh * 64);
        } else {
            const int h = hh - 8; m = -INFINITY; l = 0.f;
            for (int g = 0; g < 3; ++g) { const int dil = g == 0 ? 1 : g == 1 ? 4 : 16;
                load_row64(hrow + 768 + g * 256 + h * 64, q, 0.125f);
                for (int j = -64; j <= 64; ++j) { const int kp = pos + dil * j; if (kp < 0 || kp >= T) continue;
                    const bf16* kr = H + (size_t)(sb + kp) * EVEN_IN;
                    attend(kr + 1536 + g * 256 + h * 64, kr + 2304 + g * 256 + h * 64, q, t5[t5_bucket(dil * j) * 20 + 8 + g * 4 + h], m, l, o); } }
            gate_store64(o, l, hrow + 3584 + h * 64, Y + (size_t)tok * EVEN_OUT + 512 + h * 64);
        }
    }
}
__device__ __forceinline__ void naive_na(const bf16* H, bf16* Y, int T, const float* rpb, int gtid, int gstride) {
    const int rows = T / 64;
    for (int it = gtid; it < MC * 8; it += gstride) {
        const int h = it / MC, tok = it - h * MC, pos = tok % T, sb = tok - pos, r = pos >> 6, c = pos & 63;
        const int sr = min(max(r - 4, 0), rows - 8), sc = min(max(c - 8, 0), 48);
        float q[64], o[64], m = -INFINITY, l = 0.f;
#pragma unroll
        for (int d = 0; d < 64; ++d) o[d] = 0.f;
        const bf16* hrow = H + (size_t)tok * ODD_IN;
        load_row64(hrow + h * 64, q, 0.125f);
        for (int kr = sr; kr < sr + 8; ++kr)
            for (int kc = sc; kc < sc + 16; ++kc) { const bf16* krow = H + (size_t)(sb + kr * 64 + kc) * ODD_IN;
                attend(krow + 512 + h * 64, krow + 1024 + h * 64, q, rpb[(h * 15 + (kr - r + 7)) * 31 + (kc - c + 15)], m, l, o); }
        gate_store64(o, l, hrow + 3584 + h * 64, Y + (size_t)tok * ODD_OUT + h * 64);
    }
}
__device__ __forceinline__ void naive_hgrn(const bf16* H, float* O, int T, int nseq, const float* lb_d, LAS unsigned char* lds, int tid, int bid, int G) {
    LAS float* Fs = (LAS float*)lds; LAS float* Qs = Fs + 32 * 128; LAS float* Vs = Qs + 32 * 128; LAS float* Op = Vs + 32 * 128;
    const int dkg = tid >> 7, dv = tid & 127;
    for (int ch = bid; ch < nseq * 8; ch += G) {
        const int seq = ch >> 3, dir = (ch >> 2) & 1, head = ch & 3;
        float S[32];
#pragma unroll
        for (int i = 0; i < 32; ++i) S[i] = 0.f;
        const int zcol = 2560 + dir * 512 + head * 128;
        for (int t0 = 0; t0 < T; t0 += 32) {
            for (int e = tid; e < 32 * 128; e += 512) { const int tt = e >> 7, c = e & 127; const int t = t0 + tt, pos = dir ? T - 1 - t : t;
                const bf16* hr = H + (size_t)(seq * T + pos) * ODD_IN;
                const float a0 = lb_d[(dir * 2 + 0) * 512 + head * 128 + c], a1 = lb_d[(dir * 2 + 1) * 512 + head * 128 + c];
                const float lb = sigmoidf_(a1 - a0);
                Fs[e] = lb + (1.f - lb) * sigmoidf_(bf2f(hr[zcol + c])); Qs[e] = bf2f(hr[1536 + head * 128 + c]); Vs[e] = bf2f(hr[2048 + head * 128 + c]); }
            __syncthreads();
            for (int tt = 0; tt < 32; ++tt) { const float v = Vs[tt * 128 + dv]; float acc = 0.f;
#pragma unroll
                for (int i = 0; i < 32; ++i) { const float ff = Fs[tt * 128 + dkg * 32 + i]; S[i] = ff * S[i] + (1.f - ff) * v; acc += Qs[tt * 128 + dkg * 32 + i] * S[i]; }
                Op[(tt * 4 + dkg) * 128 + dv] = acc; }
            __syncthreads();
            for (int e = tid; e < 32 * 128; e += 512) { const int tt = e >> 7, c = e & 127; const int t = t0 + tt, pos = dir ? T - 1 - t : t;
                O[((size_t)dir * MC + seq * T + pos) * 512 + head * 128 + c] = (Op[(tt * 4 + 0) * 128 + c] + Op[(tt * 4 + 1) * 128 + c]) + (Op[(tt * 4 + 2) * 128 + c] + Op[(tt * 4 + 3) * 128 + c]); }
            __syncthreads();
        }
    }
}
__device__ __forceinline__ void hgrn_combine(const bf16* H, const float* O, bf16* Y, const float* gnorm, int gw, int NGW, int lane) {
    for (int it = gw; it < MC * 2; it += NGW) { const int tok = it >> 1, col = (it & 1) * 256 + lane * 4;
        const f32x4 a = *(const GAS f32x4*)(O + (size_t)tok * 512 + col), b = *(const GAS f32x4*)(O + ((size_t)MC + tok) * 512 + col);
        const f32x4 od = a + b; float ss = od.x * od.x + od.y * od.y + od.z * od.z + od.w * od.w;
#pragma unroll
        for (int o = 1; o < 32; o <<= 1) ss += __shfl_xor(ss, o);
        const float r = 1.f / sqrtf(ss * (1.f / 128.f) + RMS_EPS);
        const f32x4 gn = *(const GAS f32x4*)(gnorm + col);
        const unsigned long long gg = *(const GAS unsigned long long*)(H + (size_t)tok * ODD_IN + 4096 + col);
        const unsigned g0 = (unsigned)gg, g1 = (unsigned)(gg >> 32);
        const unsigned long long w = (unsigned long long)pk2(od.x * r * gn.x * siluf_(bflo(g0)), od.y * r * gn.y * siluf_(bfhi(g0)))
                                   | ((unsigned long long)pk2(od.z * r * gn.z * siluf_(bflo(g1)), od.w * r * gn.w * siluf_(bfhi(g1))) << 32);
        *(GAS unsigned long long*)(Y + (size_t)tok * ODD_OUT + 512 + col) = w; }
}
__device__ __forceinline__ void ln_row(const float* zrow, const float* g, const float* b, float* outf, bf16* outb, int lane) {
    const GAS f32x4* xr = (const GAS f32x4*)zrow + lane;
    f32x4 v[4]; float s = 0.f;
#pragma unroll
    for (int j = 0; j < 4; ++j) { v[j] = xr[64 * j]; s += (v[j].x + v[j].y) + (v[j].z + v[j].w); }
    const float mean = wave_sum(s) * (1.f / DM); float s2 = 0.f;
#pragma unroll
    for (int j = 0; j < 4; ++j) { v[j] = v[j] - mean; s2 += (v[j].x * v[j].x + v[j].y * v[j].y) + (v[j].z * v[j].z + v[j].w * v[j].w); }
    const float rstd = 1.f / sqrtf(wave_sum(s2) * (1.f / DM) + LN_EPS);
#pragma unroll
    for (int j = 0; j < 4; ++j) { const f32x4 gg = *((const GAS f32x4*)g + lane + 64 * j), bb = *((const GAS f32x4*)b + lane + 64 * j);
        const f32x4 o = v[j] * rstd * gg + bb;
        *((GAS f32x4*)outf + lane + 64 * j) = o;
        if (outb) *((GAS unsigned long long*)outb + lane + 64 * j) = (unsigned long long)pk2(o.x, o.y) | ((unsigned long long)pk2(o.z, o.w) << 32); }
}

constexpr int PARAM_OFF = LDSCTL_OFF + 512;
enum { P_XP = 0, P_XS, P_T5, P_WIE, P_SINK, P_WOE, P_WIO, P_RPB, P_LBD, P_GN, P_WOO, P_LNG, P_LNB, P_OUT, P_WS, NPARAM };
template <class Tp> __device__ __forceinline__ Tp* ldp(LAS unsigned char* lds, int i) {
    volatile LAS unsigned* PB = (volatile LAS unsigned*)(lds + PARAM_OFF);
    const unsigned lo = __builtin_amdgcn_readfirstlane(PB[2 * i]), hi = __builtin_amdgcn_readfirstlane(PB[2 * i + 1]);
    return (Tp*)(((unsigned long long)hi << 32) | lo);
}
struct Ctx { int tid, lane, wave, bid, G, gtid, gstride, gw, NGW; };
__device__ __forceinline__ Ctx mkctx() {
    Ctx c; int t = threadIdx.x; asm volatile("" : "+v"(t));
    c.tid = t; c.lane = t & 63; c.wave = __builtin_amdgcn_readfirstlane(t >> 6); c.bid = blockIdx.x; c.G = gridDim.x;
    c.gtid = c.bid * (NWAVES * 64) + t; c.gstride = c.G * NWAVES * 64; c.gw = c.bid * NWAVES + c.wave; c.NGW = c.G * NWAVES; return c;
}
struct Chunk { int row0, T, nseq; bool is_p; };
__device__ __forceinline__ Chunk mkchunk(int c) { Chunk k; k.row0 = c * MC; k.is_p = k.row0 < NP_TOK; k.T = k.is_p ? T_P : T_S; k.nseq = MC / k.T; return k; }
__device__ __forceinline__ const float* chunk_x(LAS unsigned char* lds, const Chunk& k) {
    return k.is_p ? ldp<const float>(lds, P_XP) + (size_t)k.row0 * DM : ldp<const float>(lds, P_XS) + (size_t)(k.row0 - NP_TOK) * DM; }
__device__ __forceinline__ void grid_bar(LAS unsigned char* lds) {
    XcdBarrier b; b.bar = (unsigned*)(ldp<unsigned char>(lds, P_WS) + WS_CTL) + CW_BAR; b.x = xb_xcc_id(); b.st = (volatile LAS unsigned*)(lds + MISC_OFF) + 8;
    xcd_barrier(b);
}

__device__ __forceinline__ void ph_weights(LAS unsigned char* lds) {
    const Ctx x = mkctx(); unsigned char* ws = ldp<unsigned char>(lds, P_WS);
    LAS float* scr = (LAS float*)(lds + x.wave * 16384);
    constexpr int I1 = (DM / 64) * (EVEN_IN / 32), I2 = (EVEN_OUT / 64) * (DM / 32), I3 = (DM / 64) * (ODD_IN / 32), I4 = (ODD_OUT / 64) * (DM / 32);
    for (int it = x.gw; it < I1 + I2 + I3 + I4; it += x.NGW) {
        int r = it;
        if (r < I1) { p0_transpose_item(ldp<const float>(lds, P_WIE), DM, EVEN_IN, (bf16*)(ws + WS_W1), scr, r, x.lane); continue; } r -= I1;
        if (r < I2) { p0_transpose_item(ldp<const float>(lds, P_WOE), EVEN_OUT, DM, (bf16*)(ws + WS_W2), scr, r, x.lane); continue; } r -= I2;
        if (r < I3) { p0_transpose_item(ldp<const float>(lds, P_WIO), DM, ODD_IN, (bf16*)(ws + WS_W3), scr, r, x.lane); continue; } r -= I3;
        p0_transpose_item(ldp<const float>(lds, P_WOO), ODD_OUT, DM, (bf16*)(ws + WS_W4), scr, r, x.lane);
    }
}
__device__ __forceinline__ void ph_convert(LAS unsigned char* lds, int c) {
    const Ctx x = mkctx(); const Chunk k = mkchunk(c); const float* xin = chunk_x(lds, k); bf16* XB = (bf16*)(ldp<unsigned char>(lds, P_WS) + WS_XB);
    for (int i = x.gtid; i < MC * DM / 8; i += x.gstride) { const f32x4 a = ((const GAS f32x4*)xin)[2 * i], b = ((const GAS f32x4*)xin)[2 * i + 1];
        v4u w; w.x = pk2(a.x, a.y); w.y = pk2(a.z, a.w); w.z = pk2(b.x, b.y); w.w = pk2(b.z, b.w); ((GAS v4u*)XB)[i] = w; }
}
template <int WOFF, int N> __device__ __forceinline__ void ph_gemm_in(LAS unsigned char* lds) {
    unsigned char* ws = ldp<unsigned char>(lds, P_WS);
    pg8::Gemm g{(const pg8::bf16_t*)(ws + WS_XB), (const pg8::bf16_t*)(ws + WOFF), MC, N, DM}; pg8::StaticOrder S; S.init(MC, N, (int)gridDim.x, (int)blockIdx.x);
    pg8::EpiBf16<0> E{(pg8::bf16_t*)(ws + WS_H), N, nullptr, 0, 0, 1.f};
    pg8::gemm_phase<pg8::EpiBf16<0>, pg8::StaticOrder, true, true>(lds, g, S, E);
}
template <int WOFF, int K> __device__ __forceinline__ void ph_gemm_out(LAS unsigned char* lds, const float* base) {
    unsigned char* ws = ldp<unsigned char>(lds, P_WS);
    pg8::Gemm g{(const pg8::bf16_t*)(ws + WS_Y), (const pg8::bf16_t*)(ws + WOFF), MC, DM, K}; pg8::StaticOrder S; S.init(MC, DM, (int)gridDim.x, (int)blockIdx.x);
    EpiResF32 E{base, (float*)(ws + WS_Z), DM, ALPHA};
    pg8::gemm_phase<EpiResF32, pg8::StaticOrder, true, true>(lds, g, S, E);
}
__device__ __forceinline__ void ph_ln(LAS unsigned char* lds, int c, int layer, bool to_bf16) {
    const Ctx x = mkctx(); const Chunk k = mkchunk(c); unsigned char* ws = ldp<unsigned char>(lds, P_WS);
    const float* Z = (const float*)(ws + WS_Z); float* outc = ldp<float>(lds, P_OUT) + (size_t)k.row0 * DM; bf16* XB = (bf16*)(ws + WS_XB);
    const float* g = ldp<const float>(lds, P_LNG) + layer * DM; const float* b = ldp<const float>(lds, P_LNB) + layer * DM;
    for (int m = x.gw; m < MC; m += x.NGW) ln_row(Z + (size_t)m * DM, g, b, outc + (size_t)m * DM, to_bf16 ? XB + (size_t)m * DM : nullptr, x.lane);
}
__device__ __forceinline__ void ph_even_mix(LAS unsigned char* lds, int c) {
    const Ctx x = mkctx(); const Chunk k = mkchunk(c); unsigned char* ws = ldp<unsigned char>(lds, P_WS);
    naive_even((const bf16*)(ws + WS_H), (bf16*)(ws + WS_Y), k.T, ldp<const float>(lds, P_T5), ldp<const float>(lds, P_SINK), x.gtid, x.gstride);
}
__device__ __forceinline__ void ph_odd_mix(LAS unsigned char* lds, int c) {
    const Ctx x = mkctx(); const Chunk k = mkchunk(c); unsigned char* ws = ldp<unsigned char>(lds, P_WS);
    naive_na((const bf16*)(ws + WS_H), (bf16*)(ws + WS_Y), k.T, ldp<const float>(lds, P_RPB), x.gtid, x.gstride);
    naive_hgrn((const bf16*)(ws + WS_H), (float*)(ws + WS_O), k.T, k.nseq, ldp<const float>(lds, P_LBD), lds, x.tid, x.bid, x.G);
}
__device__ __forceinline__ void ph_odd_combine(LAS unsigned char* lds) {
    const Ctx x = mkctx(); unsigned char* ws = ldp<unsigned char>(lds, P_WS);
    hgrn_combine((const bf16*)(ws + WS_H), (const float*)(ws + WS_O), (bf16*)(ws + WS_Y), ldp<const float>(lds, P_GN), x.gw, x.NGW, x.lane);
}

struct Args { const float* in[13]; float* out; unsigned char* ws; int pad0, pad1; };
__global__ void __launch_bounds__(NWAVES * 64, 2) mk_fwd(Args args) {
    extern __shared__ __attribute__((aligned(16))) unsigned char lds_raw[];
    LAS unsigned char* lds = (LAS unsigned char*)lds_raw;
    for (int u = threadIdx.x; u < (LDS_BYTES - LDSCTL_OFF) / 4; u += NWAVES * 64) ((LAS unsigned*)(lds + LDSCTL_OFF))[u] = 0u;
    __syncthreads();
    if (threadIdx.x == 0) { volatile LAS unsigned* PB = (volatile LAS unsigned*)(lds + PARAM_OFF);
#pragma unroll
        for (int i = 0; i < 13; ++i) { const unsigned long long p = (unsigned long long)args.in[i]; PB[2 * i] = (unsigned)p; PB[2 * i + 1] = (unsigned)(p >> 32); }
        { const unsigned long long p = (unsigned long long)args.out; PB[2 * P_OUT] = (unsigned)p; PB[2 * P_OUT + 1] = (unsigned)(p >> 32); }
        { const unsigned long long p = (unsigned long long)args.ws; PB[2 * P_WS] = (unsigned)p; PB[2 * P_WS + 1] = (unsigned)(p >> 32); } }
    __syncthreads();
    (void)xcd_barrier_post((unsigned*)(ldp<unsigned char>(lds, P_WS) + WS_CTL) + CW_BAR, (volatile LAS unsigned*)(lds + MISC_OFF) + 8);

    ph_weights(lds);
    for (int c = 0; c < NCH; ++c) {
        ph_convert(lds, c);                       grid_bar(lds);
        ph_gemm_in<(int)WS_W1, EVEN_IN>(lds);      grid_bar(lds);
        ph_even_mix(lds, c);                      grid_bar(lds);
        { const Chunk k = mkchunk(c); ph_gemm_out<(int)WS_W2, EVEN_OUT>(lds, chunk_x(lds, k)); }   grid_bar(lds);
        ph_ln(lds, c, 0, true);                   grid_bar(lds);
        ph_gemm_in<(int)WS_W3, ODD_IN>(lds);       grid_bar(lds);
        ph_odd_mix(lds, c);                       grid_bar(lds);
        ph_odd_combine(lds);                      grid_bar(lds);
        { const Chunk k = mkchunk(c); ph_gemm_out<(int)WS_W4, ODD_OUT>(lds, ldp<const float>(lds, P_OUT) + (size_t)k.row0 * DM); }   grid_bar(lds);
        ph_ln(lds, c, 1, false);                  grid_bar(lds);
    }
}

extern "C" void kernel_launch(void* const* d_in, const int* in_sizes, int n_in, void* d_out, int out_size, void* d_ws, size_t ws_size, hipStream_t stream) {
    static int grid = 0;
    if (grid == 0) {
        if (n_in != 13 || out_size != NTOK * DM || ws_size < WS_END) { fprintf(stderr, "kernel_launch: unexpected shapes (n_in %d out %d ws %zu)\n", n_in, out_size, ws_size); grid = -1; return; }
        int dev = 0, cus = 0, per_cu = 0;
        (void)hipGetDevice(&dev); (void)hipDeviceGetAttribute(&cus, hipDeviceAttributeMultiprocessorCount, dev);
        (void)hipFuncSetAttribute((const void*)mk_fwd, hipFuncAttributeMaxDynamicSharedMemorySize, LDS_BYTES);
        (void)hipOccupancyMaxActiveBlocksPerMultiprocessor(&per_cu, (const void*)mk_fwd, NWAVES * 64, LDS_BYTES);
        (void)hipGetLastError();
        if (per_cu < 1) { fprintf(stderr, "kernel_launch: occupancy query says %d blocks per CU\n", per_cu); }
        grid = cus;
    }
    if (grid < 0) return;
    (void)hipMemsetAsync((char*)d_ws + WS_CTL, 0, CTL_ZERO_BYTES, stream);
    Args a{};
    for (int i = 0; i < 13; ++i) a.in[i] = (const float*)d_in[i];
    a.out = (float*)d_out; a.ws = (unsigned char*)d_ws;
    void* kargs[] = {&a};
    hipError_t e = hipLaunchCooperativeKernel((const void*)mk_fwd, dim3(grid), dim3(NWAVES * 64), kargs, LDS_BYTES, stream);
    if (e != hipSuccess) fprintf(stderr, "kernel_launch: cooperative launch failed: %s (grid %d)\n", hipGetErrorString(e), grid);
}
```

```cpp
#define NAIVE_EVEN 0
#define NAIVE_NA 0
#include <hip/hip_runtime.h>
#include <cstdio>
#include <cstdint>
namespace pg8 {
#define PG8_LAS __attribute__((address_space(3)))
typedef unsigned short bf16_t;
typedef short bf16x8 __attribute__((ext_vector_type(8)));
typedef float f32x4 __attribute__((ext_vector_type(4)));
typedef unsigned u32x4 __attribute__((ext_vector_type(4)));
constexpr int BM = 256, BK = 64, HALF = 128, HTB = HALF * BK * 2  , STAGE_BYTES = 8 * HTB, NXCD = 8, WGM = 8;

__host__ __device__ __forceinline__ int lds_byte(int r, int c) { const int st = (r >> 4) * 2 + (c >> 5), rr = r & 15, cc = c & 31, ob = rr * 64 + cc * 2; return st * 1024 + (ob ^ (((ob >> 9) & 1) << 5)); }
__host__ __device__ __forceinline__ void stage_rc(int b, int& R, int& C) { const int st = b / 1024, sb = b % 1024, swz = sb ^ (((sb >> 9) & 1) << 5); R = (st >> 1) * 16 + swz / 64; C = (st & 1) * 32 + (swz % 64) / 2; }
__host__ __device__ __forceinline__ int perm32(int rho) { const int n = rho >> 4, i = rho & 15; return 8 * (i >> 2) + 4 * n + (i & 3); }

struct Unit { int pm, pn; };
struct Gemm { const bf16_t* A; const bf16_t* Bt; int M, N, K; };

struct StaticOrder {
    int nM, nN, nwg, G, c;
    __host__ __device__ void init(int M, int N, int G_, int c_) { nM = M / BM; nN = N / BM; nwg = nM * nN; G = G_; c = c_; }
    __host__ __device__ bool next(int i, Unit& u) const {
        const long L = (long)i * G + c; if (L >= nwg) return false;
        int wgid = (int)L; { const int q = nwg / NXCD, r = nwg % NXCD, xcd = wgid % NXCD, off = wgid / NXCD; wgid = (xcd < r ? xcd * (q + 1) : r * (q + 1) + (xcd - r) * q) + off; }
        const int nig = WGM * nN, gid = wgid / nig, fm = gid * WGM, gsz = (nM - fm) < WGM ? (nM - fm) : WGM;
        u.pm = fm + ((wgid % nig) % gsz); u.pn = (wgid % nig) / gsz; return true;
    }
    __device__ __forceinline__ void a_ready(const Unit&) const {}
    __device__ __forceinline__ void done(const Unit&) const {}
};

__device__ __forceinline__ unsigned cvt_pk_bf16(float lo, float hi) { unsigned r; asm volatile("v_cvt_pk_bf16_f32 %0, %1, %2" : "=v"(r) : "v"(lo), "v"(hi)); return r; }
typedef float f32x2 __attribute__((ext_vector_type(2)));
__device__ __forceinline__ f32x2 gelu_pk(f32x2 v) {
    const f32x2 av = __builtin_elementwise_abs(v), d = av * 0.2316418882f + 1.0f;
    f32x2 t; t.x = __builtin_amdgcn_rcpf(d.x); t.y = __builtin_amdgcn_rcpf(d.y);
    f32x2 q = t * 0.5307027145f + (-0.7265760135f); q = q * t + 0.7107068705f; q = q * t + (-0.142248368f); q = q * t + 0.127414796f; q = q * t;
    const f32x2 s = (v * v) * (-0.72134752044f);
    f32x2 e; e.x = __builtin_amdgcn_exp2f(s.x); e.y = __builtin_amdgcn_exp2f(s.y);
    const f32x2 m = v * (q * e), r = v - m;
    f32x2 o; o.x = v.x < 0.f ? m.x : r.x; o.y = v.y < 0.f ? m.y : r.y; return o;
}

template <int ACT  > struct EpiBf16 {
    static constexpr bool PERM = true, AFTER_DRAIN = false; static_assert(ACT == 0 || ACT == 1, "EpiBf16: ACT is 0 (none) or 1 (gelu_pk)");
    bf16_t* O; int ldc; const float* bias; int split_cols; size_t split_stride; float scale0;
    __device__ __forceinline__ void operator()(const f32x4 (&acc)[2][2][4][2], const Unit& u, int wr, int wc, int fr, int fq) const {
        const int row0 = u.pm * BM + wr * 64 + fr; int colt = u.pn * BM; bf16_t* base = O;
        float sc = 1.f; if (split_cols) { const int t = colt / split_cols; base += (size_t)t * split_stride; colt -= t * split_cols; if (t == 0) sc = scale0; }
        const int col0 = colt + wc * 32 + 8 * fq, bcol0 = u.pn * BM + wc * 32 + 8 * fq;
        f32x4 bv[2][2];
#pragma unroll
        for (int bj = 0; bj < 2; ++bj)
#pragma unroll
            for (int n = 0; n < 2; ++n) bv[bj][n] = bias ? *(const f32x4*)(bias + bcol0 + bj * HALF + 4 * n) : (f32x4){0.f, 0.f, 0.f, 0.f};
#pragma unroll
        for (int ai = 0; ai < 2; ++ai)
#pragma unroll
            for (int m = 0; m < 4; ++m) { bf16_t* rowp = base + (size_t)(row0 + ai * HALF + m * 16) * ldc + col0;
#pragma unroll
                for (int bj = 0; bj < 2; ++bj) { f32x4 v0 = acc[ai][bj][m][0] + bv[bj][0], v1 = acc[ai][bj][m][1] + bv[bj][1];
                    if (ACT == 1) { f32x2 a = gelu_pk((f32x2){v0[0], v0[1]}), b = gelu_pk((f32x2){v0[2], v0[3]}), c = gelu_pk((f32x2){v1[0], v1[1]}), d = gelu_pk((f32x2){v1[2], v1[3]});
                        v0 = (f32x4){a.x, a.y, b.x, b.y}; v1 = (f32x4){c.x, c.y, d.x, d.y}; }
                    v0 = v0 * sc; v1 = v1 * sc; u32x4 w; w.x = cvt_pk_bf16(v0[0], v0[1]); w.y = cvt_pk_bf16(v0[2], v0[3]); w.z = cvt_pk_bf16(v1[0], v1[1]); w.w = cvt_pk_bf16(v1[2], v1[3]);
                    *(u32x4*)(rowp + bj * HALF) = w; } }
    }
};

struct PanelStats {
    unsigned* xbuf;
    unsigned* cnt;
    unsigned* tmo;
    int ntn; float eps;
    unsigned code;
    __device__ __forceinline__ bool run(const f32x4 (&v)[2][2][4][2], const Unit& u, int wr, int wc, int fr, int fq, PG8_LAS unsigned char* lds, int wid, int lane) const {
        typedef float f32x2v __attribute__((ext_vector_type(2)));
        PG8_LAS f32x2v* P = (PG8_LAS f32x2v*)lds;
        PG8_LAS f32x2v* S = (PG8_LAS f32x2v*)(lds + 8192);
        PG8_LAS unsigned* flag = (PG8_LAS unsigned*)(lds + 8192 + 2048);
#pragma unroll
        for (int ai = 0; ai < 2; ++ai)
#pragma unroll
            for (int m = 0; m < 4; ++m) {
                float s = 0.f;
#pragma unroll
                for (int bj = 0; bj < 2; ++bj)
#pragma unroll
                    for (int n = 0; n < 2; ++n) { const f32x4 x = v[ai][bj][m][n]; s += (x[0] + x[1]) + (x[2] + x[3]); }
                s += __shfl_xor(s, 16); s += __shfl_xor(s, 32);
                const float mw = s * (1.0f / 64.0f); float q = 0.f;
#pragma unroll
                for (int bj = 0; bj < 2; ++bj)
#pragma unroll
                    for (int n = 0; n < 2; ++n) { const f32x4 d = v[ai][bj][m][n] - mw; q += (d[0] * d[0] + d[1] * d[1]) + (d[2] * d[2] + d[3] * d[3]); }
                q += __shfl_xor(q, 16); q += __shfl_xor(q, 32);
                if (fq == 0) P[(ai * HALF + wr * 64 + m * 16 + fr) * 4 + wc] = (f32x2v){mw, q};
            }
        asm volatile("s_waitcnt lgkmcnt(0)" ::: "memory"); __builtin_amdgcn_s_barrier(); asm volatile("" ::: "memory");
#if defined(BROKEN_EXCHANGE_NO_WAIT)
#warning BROKEN CONTROL BUILD: the row-statistics exchange does not wait; results are wrong by design
        if (blockIdx.x >= 64) { const long long t0_ = clock64(); while (clock64() - t0_ < 60000) __builtin_amdgcn_s_sleep(8); }
#endif
        const int row = wid * 32 + (lane & 31);
        if (lane < 32) {
            const f32x2v a = P[row * 4 + 0], b = P[row * 4 + 1], c = P[row * 4 + 2], d = P[row * 4 + 3];
            const float mt = (a.x + b.x + c.x + d.x) * 0.25f;
            const float da = a.x - mt, db = b.x - mt, dc = c.x - mt, dd = d.x - mt;
            const float m2 = (a.y + b.y) + (c.y + d.y) + 64.0f * ((da * da + db * db) + (dc * dc + dd * dd));
            unsigned long long* slot = (unsigned long long*)xbuf + ((size_t)(u.pm * BM + row) * 4 + u.pn);
            __hip_atomic_store(slot, ((unsigned long long)__float_as_uint(m2) << 32) | __float_as_uint(mt), __ATOMIC_RELAXED, __HIP_MEMORY_SCOPE_AGENT);
        }
        asm volatile("s_waitcnt vmcnt(0)" ::: "memory");
        if (lane == 0) __hip_atomic_fetch_add(cnt + 64 * u.pm, 1u, __ATOMIC_RELAXED, __HIP_MEMORY_SCOPE_AGENT);
        if (wid == 0) {
            bool dead = false; const unsigned long long t0 = __builtin_amdgcn_s_memrealtime(); const unsigned want = 8u * (unsigned)ntn;
            for (;;) {
#if defined(BROKEN_EXCHANGE_NO_WAIT)
                break;
#endif
                if ((unsigned)__builtin_amdgcn_readfirstlane(__hip_atomic_load(cnt + 64 * u.pm, __ATOMIC_RELAXED, __HIP_MEMORY_SCOPE_AGENT)) >= want) break;
                if (__builtin_amdgcn_s_memrealtime() - t0 > 2000000ull) {
                    if (lane == 0) { unsigned expect = 0u; __hip_atomic_compare_exchange_strong(tmo + 1, &expect, code | (unsigned)(u.pm & 0xff), __ATOMIC_RELAXED, __ATOMIC_RELAXED, __HIP_MEMORY_SCOPE_AGENT);
                                     __hip_atomic_store(tmo, 1u, __ATOMIC_RELAXED, __HIP_MEMORY_SCOPE_AGENT); }
                    dead = true; break; }
                __builtin_amdgcn_s_sleep(2);
            }
            __builtin_amdgcn_fence(__ATOMIC_ACQUIRE, "agent");
            if (lane == 0) flag[0] = dead ? 1u : 0u;
        }
        asm volatile("s_waitcnt vmcnt(0) lgkmcnt(0)" ::: "memory"); __builtin_amdgcn_s_barrier(); asm volatile("" ::: "memory");
        const bool bad = flag[0] != 0u;
        if (lane < 32) {
            const unsigned long long* slot = (const unsigned long long*)xbuf + (size_t)(u.pm * BM + row) * 4; float mt[4], m2[4]; float ms = 0.f;
#pragma unroll
            for (int t = 0; t < 4; ++t) { if (t < ntn) { const unsigned long long w = __hip_atomic_load(slot + t, __ATOMIC_RELAXED, __HIP_MEMORY_SCOPE_AGENT); mt[t] = __uint_as_float((unsigned)w); m2[t] = __uint_as_float((unsigned)(w >> 32)); } else { mt[t] = 0.f; m2[t] = 0.f; } ms += mt[t]; }
            const float mean = ms / (float)ntn; float q = 0.f;
#pragma unroll
            for (int t = 0; t < 4; ++t) if (t < ntn) { const float dm = mt[t] - mean; q += m2[t] + 256.0f * dm * dm; }
            S[row] = (f32x2v){mean, 1.0f / sqrtf(q / (256.0f * (float)ntn) + eps)};
        }
        asm volatile("s_waitcnt lgkmcnt(0)" ::: "memory"); __builtin_amdgcn_s_barrier(); asm volatile("" ::: "memory");
        return bad;
    }
};
struct EpiLnRes {
    static constexpr bool PERM = false, AFTER_DRAIN = true;
    const float* base; float* out; int ldc; const float* bias; PanelStats st; unsigned poison;
    __device__ __forceinline__ void fused(f32x4 (&acc)[2][2][4][2], const Unit& u, int wr, int wc, int fr, int fq, PG8_LAS unsigned char* lds, int wid, int lane) const {
        typedef float f32x2v __attribute__((ext_vector_type(2)));
        const PG8_LAS f32x2v* S = (const PG8_LAS f32x2v*)(lds + 8192);
        const int col0 = u.pn * BM + wc * 32 + 4 * fq;
#pragma unroll
        for (int bj = 0; bj < 2; ++bj)
#pragma unroll
            for (int n = 0; n < 2; ++n) { const f32x4 bv = bias ? *(const f32x4*)(bias + col0 + bj * HALF + n * 16) : (f32x4){0.f, 0.f, 0.f, 0.f};
#pragma unroll
                for (int ai = 0; ai < 2; ++ai)
#pragma unroll
                    for (int m = 0; m < 4; ++m) acc[ai][bj][m][n] += bv; }
        f32x4 pre[4][2][2];
#pragma unroll
        for (int m = 0; m < 4; ++m) { const size_t off = (size_t)(u.pm * BM + wr * 64 + m * 16 + fr) * ldc + col0;
#pragma unroll
            for (int bj = 0; bj < 2; ++bj)
#pragma unroll
                for (int n = 0; n < 2; ++n) pre[m][bj][n] = *(const f32x4*)(base + off + bj * HALF + n * 16); }
        const bool bad = st.run(acc, u, wr, wc, fr, fq, lds, wid, lane) || poison != 0u;
        const float qnan = __builtin_nanf("");
#pragma unroll
        for (int ai = 0; ai < 2; ++ai)
#pragma unroll
            for (int m = 0; m < 4; ++m) { const int r = ai * HALF + wr * 64 + m * 16 + fr; const f32x2v sr = S[r]; const size_t off = (size_t)(u.pm * BM + r) * ldc + col0;
#pragma unroll
                for (int bj = 0; bj < 2; ++bj)
#pragma unroll
                    for (int n = 0; n < 2; ++n) { const f32x4 bs = ai == 0 ? pre[m][bj][n] : *(const f32x4*)(base + off + bj * HALF + n * 16); f32x4 o = bs + (acc[ai][bj][m][n] - sr.x) * sr.y;
                        if (bad) o = (f32x4){qnan, qnan, qnan, qnan}; *(f32x4*)(out + off + bj * HALF + n * 16) = o; }
                if (m & 1) asm volatile("" ::: "memory"); }
    }
};
struct EpiLnResLn {
    static constexpr bool PERM = false, AFTER_DRAIN = true;
    const float* base; float* out; bf16_t* xn; int ldc; const float* bias; PanelStats st1, st2; unsigned poison;
    __device__ __forceinline__ void fused(f32x4 (&acc)[2][2][4][2], const Unit& u, int wr, int wc, int fr, int fq, PG8_LAS unsigned char* lds, int wid, int lane) const {
        typedef float f32x2v __attribute__((ext_vector_type(2))); typedef unsigned u32x2v __attribute__((ext_vector_type(2)));
        const PG8_LAS f32x2v* S = (const PG8_LAS f32x2v*)(lds + 8192);
        const int col0 = u.pn * BM + wc * 32 + 4 * fq;
#pragma unroll
        for (int bj = 0; bj < 2; ++bj)
#pragma unroll
            for (int n = 0; n < 2; ++n) { const f32x4 bv = bias ? *(const f32x4*)(bias + col0 + bj * HALF + n * 16) : (f32x4){0.f, 0.f, 0.f, 0.f};
#pragma unroll
                for (int ai = 0; ai < 2; ++ai)
#pragma unroll
                    for (int m = 0; m < 4; ++m) acc[ai][bj][m][n] += bv; }
        bool bad = st1.run(acc, u, wr, wc, fr, fq, lds, wid, lane) || poison != 0u;
        const float qnan = __builtin_nanf("");
#pragma unroll
        for (int ai = 0; ai < 2; ++ai)
#pragma unroll
            for (int m = 0; m < 4; ++m) { const int r = ai * HALF + wr * 64 + m * 16 + fr; const f32x2v sr = S[r]; const size_t off = (size_t)(u.pm * BM + r) * ldc + col0;
#pragma unroll
                for (int bj = 0; bj < 2; ++bj)
#pragma unroll
                    for (int n = 0; n < 2; ++n) { const f32x4 bs = *(const f32x4*)(base + off + bj * HALF + n * 16); acc[ai][bj][m][n] = bs + (acc[ai][bj][m][n] - sr.x) * sr.y; }
                asm volatile("" : "+v"(acc[ai][0][m][0]), "+v"(acc[ai][0][m][1]), "+v"(acc[ai][1][m][0]), "+v"(acc[ai][1][m][1]));
                if (m & 1) asm volatile("" ::: "memory"); }
        const bool bad1 = bad;
        bad = st2.run(acc, u, wr, wc, fr, fq, lds, wid, lane) || bad;
#pragma unroll
        for (int ai = 0; ai < 2; ++ai)
#pragma unroll
            for (int m = 0; m < 4; ++m) { const int r = ai * HALF + wr * 64 + m * 16 + fr; const f32x2v sr = S[r]; const size_t off = (size_t)(u.pm * BM + r) * ldc + col0;
#pragma unroll
                for (int bj = 0; bj < 2; ++bj)
#pragma unroll
                    for (int n = 0; n < 2; ++n) { const f32x4 x1 = acc[ai][bj][m][n]; *(f32x4*)(out + off + bj * HALF + n * 16) = bad1 ? (f32x4){qnan, qnan, qnan, qnan} : x1;
                        const f32x4 o = (x1 - sr.x) * sr.y; u32x2v w; w.x = cvt_pk_bf16(o[0], o[1]); w.y = cvt_pk_bf16(o[2], o[3]);
                        if (bad) { w.x = 0x7fc07fc0u; w.y = 0x7fc07fc0u; } *(u32x2v*)(xn + off + bj * HALF + n * 16) = w; }
                asm volatile("" ::: "memory"); }
    }
};

template <class Epi, class Sched, bool ALIGN_EPI = false, bool SP2 = false>
__device__ __forceinline__ void gemm_phase(PG8_LAS unsigned char* lds, const Gemm g, const Sched& S, const Epi& E) {
    int tid_ = threadIdx.x; asm volatile("" : "+v"(tid_));
    const int tid = tid_, wid = __builtin_amdgcn_readfirstlane(tid >> 6), lane = tid & 63, wr = wid >> 2, wc = wid & 3, fr = lane & 15, fq = lane >> 4;
    const int K = g.K, nt = K / BK;
    unsigned voffA[2], voffB[2];
#pragma unroll
    for (int i = 0; i < 2; ++i) { int R, C; stage_rc(tid * 16 + i * 8192, R, C); const int Rb = Epi::PERM ? ((R & ~31) + perm32(R & 31)) : R;
        voffA[i] = (unsigned)(R * K + C) * 2u; voffB[i] = (unsigned)(Rb * K + C) * 2u; }
    const size_t kstep = (size_t)(BK * 2);
    const size_t hstep = (size_t)HALF * K * 2;
    const size_t tstep = 2 * hstep;
    const unsigned ldsw = (unsigned)wid * 1024u;
    const int aoff = lds_byte(wr * 64 + fr, fq * 8), boff = lds_byte(wc * 32 + fr, fq * 8);
#define PG8_SA(b, h) (((b) * 2 + (h)) * HTB)
#define PG8_SB(b, h) ((4 + (b) * 2 + (h)) * HTB)
#define PG8_STAGE(bufoff, gbase, voff) do { _Pragma("unroll") for (int _i = 0; _i < 2; ++_i) \
        __builtin_amdgcn_global_load_lds((const unsigned*)((const char*)(gbase) + (voff)[_i]), (PG8_LAS unsigned*)(lds + (bufoff) + ldsw + _i * 8192), 16, 0, 0); } while (0)
#define PG8_LDA(dst, b, h) do { _Pragma("unroll") for (int m = 0; m < 4; ++m) _Pragma("unroll") for (int k = 0; k < 2; ++k) dst[m][k] = *(const PG8_LAS bf16x8*)(lds + PG8_SA(b, h) + aoff + m * 2048 + k * 1024); } while (0)
#define PG8_LDB(dst, b, h) do { _Pragma("unroll") for (int n = 0; n < 2; ++n) _Pragma("unroll") for (int k = 0; k < 2; ++k) dst[n][k] = *(const PG8_LAS bf16x8*)(lds + PG8_SB(b, h) + boff + n * 2048 + k * 1024); } while (0)
#define PG8_MMA(ai, bj, At, Bt) do { __builtin_amdgcn_s_setprio(1); _Pragma("unroll") for (int m = 0; m < 4; ++m) _Pragma("unroll") for (int n = 0; n < 2; ++n) _Pragma("unroll") for (int k = 0; k < 2; ++k) \
        acc[ai][bj][m][n] = __builtin_amdgcn_mfma_f32_16x16x32_bf16(Bt[n][k], At[m][k], acc[ai][bj][m][n], 0, 0, 0); __builtin_amdgcn_s_setprio(0); } while (0)
#define PG8_WAIT_V(n) asm volatile("s_waitcnt vmcnt(" #n ")" ::: "memory")
#define PG8_WAIT_L(n) asm volatile("s_waitcnt lgkmcnt(" #n ")" ::: "memory")
#define PG8_BAR __builtin_amdgcn_s_barrier()
#define PG8_SCHED __builtin_amdgcn_sched_barrier(0)
    Unit cur, nxt; int ui = 0;
    if (!S.next(0, cur)) return;
    f32x4 acc[2][2][4][2];
#pragma unroll
    for (int a = 0; a < 2; ++a)
#pragma unroll
        for (int b = 0; b < 2; ++b)
#pragma unroll
            for (int m = 0; m < 4; ++m)
#pragma unroll
                for (int n = 0; n < 2; ++n) acc[a][b][m][n] = (f32x4){0.f, 0.f, 0.f, 0.f};
    bf16x8 At[4][2], B0[2][2], B1[2][2];
    const char* cA = (const char*)g.A + (size_t)cur.pm * tstep; const char* cB = (const char*)g.Bt + (size_t)cur.pn * tstep;
    S.a_ready(cur);
    if constexpr (SP2) {
        PG8_STAGE(PG8_SB(0, 0), cB, voffB); PG8_STAGE(PG8_SB(0, 1), cB + hstep, voffB); PG8_STAGE(PG8_SA(0, 0), cA, voffA); PG8_STAGE(PG8_SA(0, 1), cA + hstep, voffA);
        if (wr == 1) PG8_BAR;
        PG8_WAIT_V(2); PG8_BAR;
        PG8_STAGE(PG8_SB(1, 0), cB + kstep, voffB); PG8_STAGE(PG8_SA(1, 0), cA + kstep, voffA); PG8_STAGE(PG8_SB(1, 1), cB + hstep + kstep, voffB);
        PG8_WAIT_V(6); PG8_BAR;
    } else {
        PG8_STAGE(PG8_SB(0, 0), cB, voffB); PG8_STAGE(PG8_SA(0, 0), cA, voffA); PG8_STAGE(PG8_SB(0, 1), cB + hstep, voffB); PG8_STAGE(PG8_SA(0, 1), cA + hstep, voffA);
        if (wr == 1) PG8_BAR;
        PG8_WAIT_V(4); PG8_BAR;
        PG8_STAGE(PG8_SB(1, 0), cB + kstep, voffB); PG8_STAGE(PG8_SA(1, 0), cA + kstep, voffA); PG8_STAGE(PG8_SB(1, 1), cB + hstep + kstep, voffB);
        PG8_WAIT_V(6); PG8_BAR;
    }
    for (;;) {
        const bool has_next = S.next(ui + 1, nxt);
        const char* nA = has_next ? (const char*)g.A + (size_t)nxt.pm * tstep : cA; const char* nB = has_next ? (const char*)g.Bt + (size_t)nxt.pn * tstep : cB;
        for (int t = 0; t < nt; t += 2) {
            const bool last = (t == nt - 2);
            const char* a1 = cA + (size_t)(t + 1) * kstep;
            const char* a2 = last ? nA : cA + (size_t)(t + 2) * kstep; const char* b2 = last ? nB : cB + (size_t)(t + 2) * kstep;
            const char* a3 = a2 + kstep; const char* b3 = b2 + kstep;
            if (last && has_next) S.a_ready(nxt);
            if constexpr (SP2) {
            PG8_LDB(B0, 0, 0); PG8_LDB(B1, 0, 1); PG8_SCHED; PG8_LDA(At, 0, 0); PG8_STAGE(PG8_SA(1, 1), a1 + hstep, voffA);
            PG8_WAIT_V(8); PG8_WAIT_L(0); PG8_BAR; PG8_MMA(0, 0, At, B0); PG8_MMA(0, 1, At, B1); PG8_BAR; PG8_SCHED;
            PG8_LDA(At, 0, 1); PG8_STAGE(PG8_SB(0, 0), b2, voffB); PG8_STAGE(PG8_SB(0, 1), b2 + hstep, voffB); PG8_STAGE(PG8_SA(0, 0), a2, voffA);
            PG8_WAIT_V(8); PG8_WAIT_L(0); PG8_BAR; PG8_MMA(1, 0, At, B0); PG8_MMA(1, 1, At, B1); PG8_BAR; PG8_SCHED;
            PG8_LDB(B0, 1, 0); PG8_LDB(B1, 1, 1); PG8_SCHED; PG8_LDA(At, 1, 0); PG8_STAGE(PG8_SA(0, 1), a2 + hstep, voffA);
            PG8_WAIT_V(8); PG8_WAIT_L(0); PG8_BAR; PG8_MMA(0, 0, At, B0); PG8_MMA(0, 1, At, B1); PG8_BAR; PG8_SCHED;
            PG8_LDA(At, 1, 1); PG8_STAGE(PG8_SB(1, 0), b3, voffB); PG8_STAGE(PG8_SB(1, 1), b3 + hstep, voffB); PG8_STAGE(PG8_SA(1, 0), a3, voffA);
            PG8_WAIT_V(8); PG8_WAIT_L(0); PG8_BAR; PG8_MMA(1, 0, At, B0); PG8_MMA(1, 1, At, B1); PG8_BAR; PG8_SCHED;
            } else {
            PG8_LDB(B0, 0, 0); PG8_SCHED; PG8_LDA(At, 0, 0); PG8_STAGE(PG8_SA(1, 1), a1 + hstep, voffA);
            PG8_WAIT_L(8); PG8_BAR; PG8_WAIT_L(0); PG8_MMA(0, 0, At, B0); PG8_BAR; PG8_SCHED;
            PG8_LDB(B1, 0, 1); PG8_STAGE(PG8_SB(0, 0), b2, voffB);
            PG8_BAR; PG8_WAIT_L(0); PG8_MMA(0, 1, At, B1); PG8_BAR;
            PG8_LDA(At, 0, 1); PG8_STAGE(PG8_SA(0, 0), a2, voffA);
            PG8_BAR; PG8_WAIT_L(0); PG8_MMA(1, 0, At, B0); PG8_BAR; PG8_SCHED;
            PG8_STAGE(PG8_SB(0, 1), b2 + hstep, voffB);
            PG8_WAIT_V(6); PG8_BAR; PG8_MMA(1, 1, At, B1); PG8_BAR;
            PG8_LDB(B0, 1, 0); PG8_SCHED; PG8_LDA(At, 1, 0); PG8_STAGE(PG8_SA(0, 1), a2 + hstep, voffA);
            PG8_WAIT_L(8); PG8_BAR; PG8_WAIT_L(0); PG8_MMA(0, 0, At, B0); PG8_BAR; PG8_SCHED;
            PG8_LDB(B1, 1, 1); PG8_STAGE(PG8_SB(1, 0), b3, voffB);
            PG8_BAR; PG8_WAIT_L(0); PG8_MMA(0, 1, At, B1); PG8_BAR;
            PG8_LDA(At, 1, 1); PG8_STAGE(PG8_SA(1, 0), a3, voffA);
            PG8_BAR; PG8_WAIT_L(0); PG8_MMA(1, 0, At, B0); PG8_BAR; PG8_SCHED;
            PG8_STAGE(PG8_SB(1, 1), b3 + hstep, voffB);
            PG8_WAIT_V(6); PG8_BAR; PG8_MMA(1, 1, At, B1); PG8_BAR;
            }
        }
        if constexpr (ALIGN_EPI) { if (wr == 0) PG8_BAR; }
        if constexpr (!Epi::AFTER_DRAIN) { E(acc, cur, wr, wc, fr, fq); S.done(cur); }
        if (!has_next) break;
#pragma unroll
        for (int a = 0; a < 2; ++a)
#pragma unroll
            for (int b = 0; b < 2; ++b)
#pragma unroll
                for (int m = 0; m < 4; ++m)
#pragma unroll
                    for (int n = 0; n < 2; ++n) acc[a][b][m][n] = (f32x4){0.f, 0.f, 0.f, 0.f};
        cur = nxt; cA = nA; cB = nB; ++ui;
        if constexpr (ALIGN_EPI) { if (wr == 1) PG8_BAR; }
    }
    PG8_WAIT_V(0);
    if constexpr (!ALIGN_EPI) { if (wr == 0) PG8_BAR; }
    PG8_BAR;
    if constexpr (Epi::AFTER_DRAIN) { E.fused(acc, cur, wr, wc, fr, fq, lds, wid, lane); S.done(cur); }
#undef PG8_SA
#undef PG8_SB
#undef PG8_STAGE
#undef PG8_LDA
#undef PG8_LDB
#undef PG8_MMA
#undef PG8_WAIT_V
#undef PG8_WAIT_L
#undef PG8_BAR
#undef PG8_SCHED
}
}
#define GAS __attribute__((address_space(1)))
#define LAS __attribute__((address_space(3)))
typedef unsigned short bf16;
typedef unsigned v4u __attribute__((ext_vector_type(4)));
typedef float f32x4 __attribute__((ext_vector_type(4)));
typedef short bf16x8 __attribute__((ext_vector_type(8)));
typedef GAS unsigned gu32;
typedef GAS unsigned long long gu64;
#define RLX_AGENT __ATOMIC_RELAXED, __HIP_MEMORY_SCOPE_AGENT
#define LDS_WAIT() asm volatile("s_waitcnt lgkmcnt(0)" ::: "memory")
#define VM_WAIT() asm volatile("s_waitcnt vmcnt(0)" ::: "memory")
__device__ __forceinline__ unsigned long long rt() { return __builtin_amdgcn_s_memrealtime(); }
__device__ __forceinline__ unsigned f2bf(float f) { unsigned u = __builtin_bit_cast(unsigned, f); return (u + 0x7fffu + ((u >> 16) & 1u)) >> 16; }
__device__ __forceinline__ unsigned pk2(float lo, float hi) { return f2bf(lo) | (f2bf(hi) << 16); }

#define XB_TMO      128
#define XB_XCNT(j)  (256  + 64 * (j))
#define XB_XSUB(j)  (1280 + 64 * (j))
#define XB_XGEN(j)  (2304 + 64 * (j))
#define XB_TOP      3328
#define XB_TOPGEN   3392
#define XCD_BAR_WORDS 3456
#define XB_SPIN_CAP (1u << 18)

__device__ __forceinline__ unsigned xb_ld(unsigned* p)              { return __hip_atomic_load(p, __ATOMIC_RELAXED, __HIP_MEMORY_SCOPE_AGENT); }
__device__ __forceinline__ unsigned xb_add(unsigned* p, unsigned v) { return __hip_atomic_fetch_add(p, v, __ATOMIC_RELAXED, __HIP_MEMORY_SCOPE_AGENT); }
__device__ __forceinline__ unsigned xb_xcc_id() { return (unsigned)__builtin_amdgcn_s_getreg((3 << 11) | 20) & 0xFu; }
#define XB_SPIN(cond, bar) do { unsigned _sp = 0; while (cond) { __builtin_amdgcn_s_sleep(1); \
    if ((++_sp & 255u) == 0u) { if (xb_ld(&(bar)[XB_TMO])) break; if (_sp > XB_SPIN_CAP) { atomicAdd(&(bar)[XB_TMO], 1u); break; } } } } while (0)

struct XcdBarrier {
    unsigned* bar; unsigned x;
    volatile LAS unsigned* st;
};

__device__ __forceinline__ XcdBarrier xcd_barrier_post(unsigned* bar, volatile LAS unsigned* st) {
    XcdBarrier b; b.bar = bar; b.x = xb_xcc_id(); b.st = st;
    if (threadIdx.x == 0) (void)xb_add(&bar[XB_XCNT(b.x)], 1u);
    return b;
}
__device__ __forceinline__ void xcd_barrier_complete(unsigned* bar, unsigned x, unsigned& nloc, unsigned& nx) {
    const unsigned G = gridDim.x * gridDim.y * gridDim.z;
    unsigned sum, cnt, mine, sp = 0u;
    for (;;) {
        sum = 0u; cnt = 0u; mine = 0u;
#pragma unroll
        for (unsigned j = 0; j < 16; ++j) { const unsigned c = xb_ld(&bar[XB_XCNT(j)]); sum += c; cnt += (c > 0u) ? 1u : 0u; mine = (j == x) ? c : mine; }
        if (sum == G) break;
        __builtin_amdgcn_s_sleep(1);
        if ((++sp & 255u) == 0u) { if (xb_ld(&bar[XB_TMO])) break; if (sp > XB_SPIN_CAP) { atomicAdd(&bar[XB_TMO], 1u); break; } }
    }
    nloc = mine > 0u ? mine : 1u; nx = cnt > 0u ? cnt : 1u;
}

__device__ __forceinline__ void xcd_barrier(const XcdBarrier& b) {
    asm volatile("s_waitcnt vmcnt(0)" ::: "memory");
    __syncthreads();
    if (threadIdx.x == 0) {
        unsigned* bar = b.bar;
        __builtin_amdgcn_s_waitcnt(0);
        unsigned nloc = b.st[0], nx = b.st[1];
        if (nloc == 0u) { xcd_barrier_complete(bar, b.x, nloc, nx); b.st[0] = nloc; b.st[1] = nx; }
        const unsigned old = xb_add(&bar[XB_XSUB(b.x)], 1u);
        const unsigned gen = old / nloc;
        if (old + 1u == (gen + 1u) * nloc) {
            __builtin_amdgcn_fence(__ATOMIC_RELEASE, "agent");
            asm volatile("s_waitcnt vmcnt(0)" ::: "memory");
            const unsigned og = xb_add(&bar[XB_TOP], 1u);
            const unsigned tg = og / nx;
            if (og + 1u == (tg + 1u) * nx) xb_add(&bar[XB_TOPGEN], 1u);
            else XB_SPIN(xb_ld(&bar[XB_TOPGEN]) == tg, bar);
            __builtin_amdgcn_fence(__ATOMIC_ACQUIRE, "agent");
            xb_add(&bar[XB_XGEN(b.x)], 1u);
            asm volatile("s_waitcnt vmcnt(0)" ::: "memory");
        } else {
            XB_SPIN(xb_ld(&bar[XB_XGEN(b.x)]) == gen, bar);
            __builtin_amdgcn_fence(__ATOMIC_ACQUIRE, "agent");
            asm volatile("s_waitcnt vmcnt(0)" ::: "memory");
        }
    }
    __syncthreads();
}

constexpr int NWAVES = 8;
constexpr int DM = 1024;
constexpr int NP_TOK = 16 * 4096, NS_TOK = 2 * 16384, NTOK = NP_TOK + NS_TOK;
constexpr int T_P = 4096, T_S = 16384;
constexpr int MC = 32768, NCH = NTOK / MC;
constexpr int EVEN_IN = 3840, EVEN_OUT = 768, ODD_IN = 4608, ODD_OUT = 1024;
constexpr float ALPHA = 1.4142135623730951f;
constexpr float LN_EPS = 1e-5f, RMS_EPS = 1e-6f;

constexpr size_t MiB = 1u << 20;
constexpr size_t WS_CTL = 0, CTL_ZERO_BYTES = 1 * MiB;
constexpr size_t WS_W1 = 2 * MiB;
constexpr size_t WS_W2 = 10 * MiB;
constexpr size_t WS_W3 = 12 * MiB;
constexpr size_t WS_W4 = 22 * MiB;
constexpr size_t WS_XB = 32 * MiB;
constexpr size_t WS_H  = 96 * MiB;
constexpr size_t WS_Y  = 384 * MiB;
constexpr size_t WS_Z  = 448 * MiB;
constexpr size_t WS_O  = 576 * MiB;
constexpr size_t WS_END = 704 * MiB;
constexpr int CW_BAR = 4096;

constexpr int RING_BYTES = 131072;
constexpr int LDSCTL_OFF = RING_BYTES, MISC_OFF = LDSCTL_OFF + 320;
constexpr int LDS_BYTES = 147456;

__device__ __forceinline__ float bf2f(unsigned short b) { return __builtin_bit_cast(float, (unsigned)b << 16); }
__device__ __forceinline__ float bflo(unsigned u) { return __builtin_bit_cast(float, u << 16); }
__device__ __forceinline__ float bfhi(unsigned u) { return __builtin_bit_cast(float, u & 0xffff0000u); }
__device__ __forceinline__ float sigmoidf_(float x) { return 1.f / (1.f + __expf(-x)); }
__device__ __forceinline__ float siluf_(float x) { return x / (1.f + __expf(-x)); }

__device__ __forceinline__ int t5_bucket(int rel) {
    const int n = rel < 0 ? -rel : rel;
    int b = n < 8 ? n : n < 15 ? 8 : n < 27 ? 9 : n < 50 ? 10 : n < 91 ? 11 : n < 166 ? 12 : n < 305 ? 13 : n < 559 ? 14 : 15;
    return b + (rel > 0 ? 16 : 0);
}

__device__ __forceinline__ float wave_sum(float v) {
#pragma unroll
    for (int o = 1; o < 64; o <<= 1) v += __shfl_xor(v, o);
    return v;
}

__device__ __forceinline__ void p0_transpose_item(const float* W, int K, int N, bf16* WT, LAS float* scr, int item, int lane) {
    const int nblk = N / 32, kb = item / nblk, nb = item % nblk, k0 = 64 * kb, n0 = 32 * nb;
#pragma unroll 8
    for (int i = 0; i < 32; ++i) { const int kk = 2 * i + (lane >> 5); scr[kk * 33 + (lane & 31)] = W[(size_t)(k0 + kk) * N + n0 + (lane & 31)]; }
    LDS_WAIT(); asm volatile("" ::: "memory");
    const int c = lane & 7;
#pragma unroll
    for (int j = 0; j < 4; ++j) { const int n = (lane >> 3) + 8 * j; const LAS float* s = scr + (8 * c) * 33 + n;
        v4u o; o.x = pk2(s[0 * 33], s[1 * 33]); o.y = pk2(s[2 * 33], s[3 * 33]); o.z = pk2(s[4 * 33], s[5 * 33]); o.w = pk2(s[6 * 33], s[7 * 33]);
        *(GAS v4u*)(WT + (size_t)(n0 + n) * K + k0 + 8 * c) = o; }
    LDS_WAIT(); asm volatile("" ::: "memory");
}

struct EpiResF32 {
    static constexpr bool PERM = false, AFTER_DRAIN = false;
    const float* base; float* out; int ldc; float alpha;
    __device__ __forceinline__ void operator()(const pg8::f32x4 (&acc)[2][2][4][2], const pg8::Unit& u, int wr, int wc, int fr, int fq) const {
        const int col0 = u.pn * pg8::BM + wc * 32 + 4 * fq;
#pragma unroll
        for (int ai = 0; ai < 2; ++ai)
#pragma unroll
            for (int m = 0; m < 4; ++m) { const size_t off = (size_t)(u.pm * pg8::BM + ai * pg8::HALF + wr * 64 + m * 16 + fr) * ldc + col0;
#pragma unroll
                for (int bj = 0; bj < 2; ++bj)
#pragma unroll
                    for (int n = 0; n < 2; ++n) { const pg8::f32x4 bs = *(const pg8::f32x4*)(base + off + bj * pg8::HALF + n * 16);
                        *(pg8::f32x4*)(out + off + bj * pg8::HALF + n * 16) = bs * alpha + acc[ai][bj][m][n]; }
                asm volatile("" ::: "memory"); }
    }
};

__device__ __forceinline__ void load_row64(const bf16* p, float (&x)[64], float scale) {
#pragma unroll
    for (int c = 0; c < 8; ++c) { const v4u w = *(const GAS v4u*)(p + c * 8);
        x[c * 8 + 0] = bflo(w.x) * scale; x[c * 8 + 1] = bfhi(w.x) * scale; x[c * 8 + 2] = bflo(w.y) * scale; x[c * 8 + 3] = bfhi(w.y) * scale;
        x[c * 8 + 4] = bflo(w.z) * scale; x[c * 8 + 5] = bfhi(w.z) * scale; x[c * 8 + 6] = bflo(w.w) * scale; x[c * 8 + 7] = bfhi(w.w) * scale; }
}
__device__ __forceinline__ void attend(const bf16* krow, const bf16* vrow, const float (&q)[64], float bias, float& m, float& l, float (&o)[64]) {
    float dot = 0.f;
#pragma unroll
    for (int c = 0; c < 8; ++c) { const v4u w = *(const GAS v4u*)(krow + c * 8);
        dot += q[c * 8 + 0] * bflo(w.x) + q[c * 8 + 1] * bfhi(w.x) + q[c * 8 + 2] * bflo(w.y) + q[c * 8 + 3] * bfhi(w.y)
             + q[c * 8 + 4] * bflo(w.z) + q[c * 8 + 5] * bfhi(w.z) + q[c * 8 + 6] * bflo(w.w) + q[c * 8 + 7] * bfhi(w.w); }
    const float s = dot + bias, mn = fmaxf(m, s), a = __expf(m - mn), p = __expf(s - mn);
    l = l * a + p; m = mn;
#pragma unroll
    for (int c = 0; c < 8; ++c) { const v4u w = *(const GAS v4u*)(vrow + c * 8);
        o[c * 8 + 0] = o[c * 8 + 0] * a + p * bflo(w.x); o[c * 8 + 1] = o[c * 8 + 1] * a + p * bfhi(w.x);
        o[c * 8 + 2] = o[c * 8 + 2] * a + p * bflo(w.y); o[c * 8 + 3] = o[c * 8 + 3] * a + p * bfhi(w.y);
        o[c * 8 + 4] = o[c * 8 + 4] * a + p * bflo(w.z); o[c * 8 + 5] = o[c * 8 + 5] * a + p * bfhi(w.z);
        o[c * 8 + 6] = o[c * 8 + 6] * a + p * bflo(w.w); o[c * 8 + 7] = o[c * 8 + 7] * a + p * bfhi(w.w); }
}
__device__ __forceinline__ void gate_store64(const float (&o)[64], float l, const bf16* gate, bf16* y) {
    const float rl = 1.f / l;
#pragma unroll
    for (int c = 0; c < 8; ++c) { const v4u g = *(const GAS v4u*)(gate + c * 8); v4u w;
        w.x = pk2(o[c * 8 + 0] * rl * siluf_(bflo(g.x)), o[c * 8 + 1] * rl * siluf_(bfhi(g.x)));
        w.y = pk2(o[c * 8 + 2] * rl * siluf_(bflo(g.y)), o[c * 8 + 3] * rl * siluf_(bfhi(g.y)));
        w.z = pk2(o[c * 8 + 4] * rl * siluf_(bflo(g.z)), o[c * 8 + 5] * rl * siluf_(bfhi(g.z)));
        w.w = pk2(o[c * 8 + 6] * rl * siluf_(bflo(g.w)), o[c * 8 + 7] * rl * siluf_(bfhi(g.w)));
        *(GAS v4u*)(y + c * 8) = w; }
}

__device__ __forceinline__ void naive_even(const bf16* H, bf16* Y, int T, const float* t5, const float* sink, int gtid, int gstride) {
    for (int it = gtid; it < MC * 12; it += gstride) {
        const int hh = it / MC, tok = it - hh * MC, pos = tok % T, sb = tok - pos;
        float q[64], o[64], m, l;
#pragma unroll
        for (int d = 0; d < 64; ++d) o[d] = 0.f;
        const bf16* hrow = H + (size_t)tok * EVEN_IN;
        if (hh < 8) {
            load_row64(hrow + hh * 64, q, 0.125f);
            m = sink[hh]; l = 1.f;
            const int kvh = hh >> 2;
            for (int rel = -128; rel <= 128; ++rel) { const int kp = pos + rel; if (kp < 0 || kp >= T) continue;
                const bf16* kr = H + (size_t)(sb + kp) * EVEN_IN;
                attend(kr + 512 + kvh * 64, kr + 640 + kvh * 64, q, t5[t5_bucket(rel) * 20 + hh], m, l, o); }
            gate_store64(o, l, hrow + 3072 + hh * 64, Y + (size_t)tok * EVEN_OUT + hh * 64);
        } else {
            const int h = hh - 8; m = -INFINITY; l = 0.f;
            for (int g = 0; g < 3; ++g) { const int dil = g == 0 ? 1 : g == 1 ? 4 : 16;
                load_row64(hrow + 768 + g * 256 + h * 64, q, 0.125f);
                for (int j = -64; j <= 64; ++j) { const int kp = pos + dil * j; if (kp < 0 || kp >= T) continue;
                    const bf16* kr = H + (size_t)(sb + kp) * EVEN_IN;
                    attend(kr + 1536 + g * 256 + h * 64, kr + 2304 + g * 256 + h * 64, q, t5[t5_bucket(dil * j) * 20 + 8 + g * 4 + h], m, l, o); } }
            gate_store64(o, l, hrow + 3584 + h * 64, Y + (size_t)tok * EVEN_OUT + 512 + h * 64);
        }
    }
}
__device__ __forceinline__ void naive_na(const bf16* H, bf16* Y, int T, const float* rpb, int gtid, int gstride) {
    const int rows = T / 64;
    for (int it = gtid; it < MC * 8; it += gstride) {
        const int h = it / MC, tok = it - h * MC, pos = tok % T, sb = tok - pos, r = pos >> 6, c = pos & 63;
        const int sr = min(max(r - 4, 0), rows - 8), sc = min(max(c - 8, 0), 48);
        float q[64], o[64], m = -INFINITY, l = 0.f;
#pragma unroll
        for (int d = 0; d < 64; ++d) o[d] = 0.f;
        const bf16* hrow = H + (size_t)tok * ODD_IN;
        load_row64(hrow + h * 64, q, 0.125f);
        for (int kr = sr; kr < sr + 8; ++kr)
            for (int kc = sc; kc < sc + 16; ++kc) { const bf16* krow = H + (size_t)(sb + kr * 64 + kc) * ODD_IN;
                attend(krow + 512 + h * 64, krow + 1024 + h * 64, q, rpb[(h * 15 + (kr - r + 7)) * 31 + (kc - c + 15)], m, l, o); }
        gate_store64(o, l, hrow + 3584 + h * 64, Y + (size_t)tok * ODD_OUT + h * 64);
    }
}
__device__ __forceinline__ void naive_hgrn(const bf16* H, float* O, int T, int nseq, const float* lb_d, LAS unsigned char* lds, int tid, int bid, int G) {
    LAS float* Fs = (LAS float*)lds; LAS float* Qs = Fs + 32 * 128; LAS float* Vs = Qs + 32 * 128; LAS float* Op = Vs + 32 * 128;
    const int dkg = tid >> 7, dv = tid & 127;
    for (int ch = bid; ch < nseq * 8; ch += G) {
        const int seq = ch >> 3, dir = (ch >> 2) & 1, head = ch & 3;
        float S[32];
#pragma unroll
        for (int i = 0; i < 32; ++i) S[i] = 0.f;
        const int zcol = 2560 + dir * 512 + head * 128;
        for (int t0 = 0; t0 < T; t0 += 32) {
            for (int e = tid; e < 32 * 128; e += 512) { const int tt = e >> 7, c = e & 127; const int t = t0 + tt, pos = dir ? T - 1 - t : t;
                const bf16* hr = H + (size_t)(seq * T + pos) * ODD_IN;
                const float a0 = lb_d[(dir * 2 + 0) * 512 + head * 128 + c], a1 = lb_d[(dir * 2 + 1) * 512 + head * 128 + c];
                const float lb = sigmoidf_(a1 - a0);
                Fs[e] = lb + (1.f - lb) * sigmoidf_(bf2f(hr[zcol + c])); Qs[e] = bf2f(hr[1536 + head * 128 + c]); Vs[e] = bf2f(hr[2048 + head * 128 + c]); }
            __syncthreads();
            for (int tt = 0; tt < 32; ++tt) { const float v = Vs[tt * 128 + dv]; float acc = 0.f;
#pragma unroll
                for (int i = 0; i < 32; ++i) { const float ff = Fs[tt * 128 + dkg * 32 + i]; S[i] = ff * S[i] + (1.f - ff) * v; acc += Qs[tt * 128 + dkg * 32 + i] * S[i]; }
                Op[(tt * 4 + dkg) * 128 + dv] = acc; }
            __syncthreads();
            for (int e = tid; e < 32 * 128; e += 512) { const int tt = e >> 7, c = e & 127; const int t = t0 + tt, pos = dir ? T - 1 - t : t;
                O[((size_t)dir * MC + seq * T + pos) * 512 + head * 128 + c] = (Op[(tt * 4 + 0) * 128 + c] + Op[(tt * 4 + 1) * 128 + c]) + (Op[(tt * 4 + 2) * 128 + c] + Op[(tt * 4 + 3) * 128 + c]); }
            __syncthreads();
        }
    }
}
__device__ __forceinline__ void hgrn_combine(const bf16* H, const float* O, bf16* Y, const float* gnorm, int gw, int NGW, int lane) {
    for (int it = gw; it < MC * 2; it += NGW) { const int tok = it >> 1, col = (it & 1) * 256 + lane * 4;
        const f32x4 a = *(const GAS f32x4*)(O + (size_t)tok * 512 + col), b = *(const GAS f32x4*)(O + ((size_t)MC + tok) * 512 + col);
        const f32x4 od = a + b; float ss = od.x * od.x + od.y * od.y + od.z * od.z + od.w * od.w;
#pragma unroll
        for (int o = 1; o < 32; o <<= 1) ss += __shfl_xor(ss, o);
        const float r = 1.f / sqrtf(ss * (1.f / 128.f) + RMS_EPS);
        const f32x4 gn = *(const GAS f32x4*)(gnorm + col);
        const unsigned long long gg = *(const GAS unsigned long long*)(H + (size_t)tok * ODD_IN + 4096 + col);
        const unsigned g0 = (unsigned)gg, g1 = (unsigned)(gg >> 32);
        const unsigned long long w = (unsigned long long)pk2(od.x * r * gn.x * siluf_(bflo(g0)), od.y * r * gn.y * siluf_(bfhi(g0)))
                                   | ((unsigned long long)pk2(od.z * r * gn.z * siluf_(bflo(g1)), od.w * r * gn.w * siluf_(bfhi(g1))) << 32);
        *(GAS unsigned long long*)(Y + (size_t)tok * ODD_OUT + 512 + col) = w; }
}
__device__ __forceinline__ void ln_row(const float* zrow, const float* g, const float* b, float* outf, bf16* outb, int lane) {
    const GAS f32x4* xr = (const GAS f32x4*)zrow + lane;
    f32x4 v[4]; float s = 0.f;
#pragma unroll
    for (int j = 0; j < 4; ++j) { v[j] = xr[64 * j]; s += (v[j].x + v[j].y) + (v[j].z + v[j].w); }
    const float mean = wave_sum(s) * (1.f / DM); float s2 = 0.f;
#pragma unroll
    for (int j = 0; j < 4; ++j) { v[j] = v[j] - mean; s2 += (v[j].x * v[j].x + v[j].y * v[j].y) + (v[j].z * v[j].z + v[j].w * v[j].w); }
    const float rstd = 1.f / sqrtf(wave_sum(s2) * (1.f / DM) + LN_EPS);
#pragma unroll
    for (int j = 0; j < 4; ++j) { const f32x4 gg = *((const GAS f32x4*)g + lane + 64 * j), bb = *((const GAS f32x4*)b + lane + 64 * j);
        const f32x4 o = v[j] * rstd * gg + bb;
        *((GAS f32x4*)outf + lane + 64 * j) = o;
        if (outb) *((GAS unsigned long long*)outb + lane + 64 * j) = (unsigned long long)pk2(o.x, o.y) | ((unsigned long long)pk2(o.z, o.w) << 32); }
}


typedef float f32x16 __attribute__((ext_vector_type(16)));
typedef short s16x4 __attribute__((ext_vector_type(4)));
typedef float f32x2_t __attribute__((ext_vector_type(2)));
typedef __bf16 bf16x2_t __attribute__((ext_vector_type(2)));
constexpr float L2E = 1.4426950408889634f, QSC = 0.125f * L2E;
__device__ __forceinline__ unsigned cvtpk(float lo, float hi) { f32x2_t v = {lo, hi}; bf16x2_t b = __builtin_convertvector(v, bf16x2_t); return __builtin_bit_cast(unsigned, b); }
__device__ __forceinline__ s16x4 vtr(LAS unsigned char* p) { return __builtin_bit_cast(s16x4, __builtin_amdgcn_ds_read_tr16_b64_v4i16((LAS s16x4*)p)); }
__device__ __forceinline__ float xhalf_max(float v) { auto rr = __builtin_amdgcn_permlane32_swap(__float_as_uint(v), __float_as_uint(v), false, false); return fmaxf(__uint_as_float(rr[0]), __uint_as_float(rr[1])); }
__device__ __forceinline__ float xhalf_sum(float v) { auto rr = __builtin_amdgcn_permlane32_swap(__float_as_uint(v), __float_as_uint(v), false, false); return __uint_as_float(rr[0]) + __uint_as_float(rr[1]); }
struct AttnSt { f32x16 o0, o1; float m, l; };

template <class RowF, class FixF>
__device__ __forceinline__ void attn_run(AttnSt& st, const bf16x8 (&qf)[4], int t_lo, int t_hi, int kcol, int vcol, RowF rowf, FixF fixf, LAS unsigned char* vl, int lane) {
    const int kvi = lane & 31, hi = lane >> 5;
    bf16x8 kn[4]; v4u vn[4];
#define ATT_LOAD(t_) do { const bf16* kr_ = rowf((t_), kvi) + kcol + 8 * hi; \
        _Pragma("unroll") for (int d0 = 0; d0 < 4; ++d0) kn[d0] = *(const GAS bf16x8*)(kr_ + d0 * 16); \
        _Pragma("unroll") for (int i = 0; i < 4; ++i) vn[i] = *(const GAS v4u*)(rowf((t_), i * 8 + (lane >> 3)) + vcol + (lane & 7) * 8); } while (0)
    if (t_lo < t_hi) ATT_LOAD(t_lo);
    LAS unsigned char* vw = vl + ((lane & 7) >> 2) * 2048 + (lane >> 3) * 64 + (lane & 3) * 16;
    LAS unsigned char* vr = vl + (4 * hi + ((lane & 15) >> 2)) * 64 + (16 * ((lane >> 4) & 1) + 4 * (lane & 3)) * 2;
    for (int t = t_lo; t < t_hi; ++t) {
        bf16x8 kf[4]; v4u vv[4];
#pragma unroll
        for (int i = 0; i < 4; ++i) { kf[i] = kn[i]; vv[i] = vn[i]; }
        if (t + 1 < t_hi) ATT_LOAD(t + 1);
#pragma unroll
        for (int i = 0; i < 4; ++i) *(LAS v4u*)(vw + i * 512) = vv[i];
        f32x16 s = {0.f, 0.f, 0.f, 0.f, 0.f, 0.f, 0.f, 0.f, 0.f, 0.f, 0.f, 0.f, 0.f, 0.f, 0.f, 0.f};
#pragma unroll
        for (int d0 = 0; d0 < 4; ++d0) s = __builtin_amdgcn_mfma_f32_32x32x16_bf16(kf[d0], qf[d0], s, 0, 0, 0);
        fixf(t, s);
        float mx = fmaxf(s[0], s[1]);
#pragma unroll
        for (int r = 2; r < 16; ++r) mx = fmaxf(mx, s[r]);
        mx = xhalf_max(mx);
        const float mn = fmaxf(st.m, mx), sc = __builtin_amdgcn_exp2f(st.m - mn);
        st.m = mn;
        float sum = 0.f;
#pragma unroll
        for (int r = 0; r < 16; ++r) { s[r] = __builtin_amdgcn_exp2f(s[r] - mn); sum += s[r]; }
        st.l = st.l * sc + sum;
        st.o0 = st.o0 * sc; st.o1 = st.o1 * sc;
        v4u p0, p1;
        p0.x = cvtpk(s[0], s[1]); p0.y = cvtpk(s[2], s[3]); p0.z = cvtpk(s[4], s[5]); p0.w = cvtpk(s[6], s[7]);
        p1.x = cvtpk(s[8], s[9]); p1.y = cvtpk(s[10], s[11]); p1.z = cvtpk(s[12], s[13]); p1.w = cvtpk(s[14], s[15]);
        const bf16x8 pf0 = __builtin_bit_cast(bf16x8, p0), pf1 = __builtin_bit_cast(bf16x8, p1);
        __builtin_amdgcn_wave_barrier();
#pragma unroll
        for (int d0 = 0; d0 < 2; ++d0) {
            const s16x4 a0 = vtr(vr + d0 * 2048), a1 = vtr(vr + d0 * 2048 + 512), b0 = vtr(vr + d0 * 2048 + 1024), b1 = vtr(vr + d0 * 2048 + 1536);
            const bf16x8 vf0 = (bf16x8){a0[0], a0[1], a0[2], a0[3], a1[0], a1[1], a1[2], a1[3]}, vf1 = (bf16x8){b0[0], b0[1], b0[2], b0[3], b1[0], b1[1], b1[2], b1[3]};
            if (d0 == 0) { st.o0 = __builtin_amdgcn_mfma_f32_32x32x16_bf16(vf0, pf0, st.o0, 0, 0, 0); st.o0 = __builtin_amdgcn_mfma_f32_32x32x16_bf16(vf1, pf1, st.o0, 0, 0, 0); }
            else         { st.o1 = __builtin_amdgcn_mfma_f32_32x32x16_bf16(vf0, pf0, st.o1, 0, 0, 0); st.o1 = __builtin_amdgcn_mfma_f32_32x32x16_bf16(vf1, pf1, st.o1, 0, 0, 0); }
        }
        __builtin_amdgcn_wave_barrier();
    }
#undef ATT_LOAD
}
__device__ __forceinline__ void attn_store(const AttnSt& st, const bf16* gate_row, bf16* y_row, int lane) {
    const int hi = lane >> 5; const float rl = 1.f / xhalf_sum(st.l);
#pragma unroll
    for (int d0 = 0; d0 < 2; ++d0)
#pragma unroll
        for (int g = 0; g < 4; ++g) { const int d = 32 * d0 + 8 * g + 4 * hi;
            const unsigned long long gg = *(const GAS unsigned long long*)(gate_row + d); const unsigned g0 = (unsigned)gg, g1 = (unsigned)(gg >> 32);
            const float a = (d0 ? st.o1[4 * g + 0] : st.o0[4 * g + 0]) * rl, b = (d0 ? st.o1[4 * g + 1] : st.o0[4 * g + 1]) * rl, c = (d0 ? st.o1[4 * g + 2] : st.o0[4 * g + 2]) * rl, e = (d0 ? st.o1[4 * g + 3] : st.o0[4 * g + 3]) * rl;
            *(GAS unsigned long long*)(y_row + d) = (unsigned long long)cvtpk(a * siluf_(bflo(g0)), b * siluf_(bfhi(g0))) | ((unsigned long long)cvtpk(c * siluf_(bflo(g1)), e * siluf_(bfhi(g1))) << 32); }
}
__device__ __forceinline__ void load_q(bf16x8 (&qf)[4], const bf16* qrow, int lane) {
#pragma unroll
    for (int d0 = 0; d0 < 4; ++d0) qf[d0] = *(const GAS bf16x8*)(qrow + d0 * 16 + 8 * (lane >> 5));
}
#define CROW(r, hi) (((r) & 3) + 8 * ((r) >> 2) + 4 * (hi))

constexpr int TA_OFF = 0, TA_N = 320;
constexpr int TB2_OFF = 10240, TB2_N = 192;
constexpr int TB1_OFF = 13312, TB1_N = 384;
constexpr int TB0_OFF = 19456, TB0_N = 1152;
constexpr int VT_OFF = 40960;
__device__ __forceinline__ void even_tables(LAS unsigned char* lds, const float* t5, int tid) {
    LAS float* ta = (LAS float*)(lds + TA_OFF); LAS float* tb2 = (LAS float*)(lds + TB2_OFF); LAS float* tb1 = (LAS float*)(lds + TB1_OFF); LAS float* tb0 = (LAS float*)(lds + TB0_OFF);
    for (int e = tid; e < 8 * TA_N; e += 512) { const int h = e / TA_N, rel = e % TA_N - 160; ta[e] = (rel >= -128 && rel <= 128) ? t5[t5_bucket(rel) * 20 + h] * L2E : -INFINITY; }
    for (int e = tid; e < 4 * TB2_N; e += 512) { const int h = e / TB2_N, rel = e % TB2_N - 96; tb2[e] = (rel >= -64 && rel <= 64) ? t5[t5_bucket(16 * rel) * 20 + 16 + h] * L2E : -INFINITY; }
    for (int e = tid; e < 4 * TB1_N; e += 512) { const int h = e / TB1_N, rel = e % TB1_N - 192; tb1[e] = (rel >= -64 && rel <= 64) ? t5[t5_bucket(4 * rel) * 20 + 12 + h] * L2E : -INFINITY; }
    for (int e = tid; e < 4 * TB0_N; e += 512) { const int h = e / TB0_N, rel = e % TB0_N - 576; tb0[e] = (rel >= -64 && rel <= 64) ? t5[t5_bucket(rel) * 20 + 8 + h] * L2E : -INFINITY; }
}
__device__ __forceinline__ void mixA_task(const bf16* H, bf16* Y, int T, const float* sink, LAS unsigned char* lds, LAS unsigned char* vl, int qt, int hh, int lane) {
    const int tok0 = qt * 32, pos0 = tok0 % T, sb = tok0 - pos0, qi = lane & 31, hi = lane >> 5, kvh = hh >> 2;
    bf16x8 qf[4]; load_q(qf, H + (size_t)(tok0 + qi) * EVEN_IN + hh * 64, lane);
    AttnSt st; st.m = sink[hh] * L2E; st.l = hi == 0 ? 1.f : 0.f;
#pragma unroll
    for (int r = 0; r < 16; ++r) { st.o0[r] = 0.f; st.o1[r] = 0.f; }
    const int t_lo = pos0 < 128 ? (128 - pos0) / 32 : 0, t_hi = min(9, (T - pos0 + 128) / 32);
    const LAS float* tab = (const LAS float*)(lds + TA_OFF) + hh * TA_N + 160 - 128 - qi + 4 * hi;
    auto rowf = [&](int t, int kvi) -> const bf16* { return H + (size_t)(sb + pos0 - 128 + 32 * t + kvi) * EVEN_IN; };
    auto fixf = [&](int t, f32x16& s) {
#pragma unroll
        for (int r = 0; r < 16; ++r) s[r] = s[r] * QSC + tab[32 * t + (r & 3) + 8 * (r >> 2)];
    };
    attn_run(st, qf, t_lo, t_hi, 512 + kvh * 64, 640 + kvh * 64, rowf, fixf, vl, lane);
    attn_store(st, H + (size_t)(tok0 + qi) * EVEN_IN + 3072 + hh * 64, Y + (size_t)(tok0 + qi) * EVEN_OUT + hh * 64, lane);
}
__device__ __forceinline__ void mixB_task(const bf16* H, bf16* Y, int T, LAS unsigned char* lds, LAS unsigned char* vl, int qt, int h, int lane) {
    const int per_seq = T / 32, seq = qt / per_seq, w = qt - seq * per_seq, r16 = w & 15, i0 = (w >> 4) * 32, sb = seq * T, qi = lane & 31, hi = lane >> 5;
    const int qpos = r16 + 16 * (i0 + qi); const size_t qrow = (size_t)(sb + qpos) * EVEN_IN;
    AttnSt st; st.m = -1e30f; st.l = 0.f;
#pragma unroll
    for (int r = 0; r < 16; ++r) { st.o0[r] = 0.f; st.o1[r] = 0.f; }
    bf16x8 qf[4];
    {
        load_q(qf, H + qrow + 768 + 2 * 256 + h * 64, lane);
        const int L = T / 16, kb = i0 - 64, t_lo = kb < 0 ? (-kb) / 32 : 0, t_hi = min(5, (L - kb) / 32);
        const LAS float* tab = (const LAS float*)(lds + TB2_OFF) + h * TB2_N + 96 - 64 - qi + 4 * hi;
        auto rowf = [&](int t, int kvi) -> const bf16* { return H + (size_t)(sb + r16 + 16 * (kb + 32 * t + kvi)) * EVEN_IN; };
        auto fixf = [&](int t, f32x16& s) {
#pragma unroll
            for (int r = 0; r < 16; ++r) s[r] = s[r] * QSC + tab[32 * t + (r & 3) + 8 * (r >> 2)]; };
        attn_run(st, qf, t_lo, t_hi, 1536 + 2 * 256 + h * 64, 2304 + 2 * 256 + h * 64, rowf, fixf, vl, lane);
    }
    {
        load_q(qf, H + qrow + 768 + 1 * 256 + h * 64, lane);
        const int L = T / 4, kb = 4 * i0 - 64, t_lo = kb < 0 ? (-kb) / 32 : 0, t_hi = min(8, (L - kb) / 32), r4 = r16 & 3;
        const LAS float* tab = (const LAS float*)(lds + TB1_OFF) + h * TB1_N + 192 - 64 - (r16 >> 2) - 4 * qi + 4 * hi;
        auto rowf = [&](int t, int kvi) -> const bf16* { return H + (size_t)(sb + r4 + 4 * (kb + 32 * t + kvi)) * EVEN_IN; };
        auto fixf = [&](int t, f32x16& s) {
#pragma unroll
            for (int r = 0; r < 16; ++r) s[r] = s[r] * QSC + tab[32 * t + (r & 3) + 8 * (r >> 2)]; };
        attn_run(st, qf, t_lo, t_hi, 1536 + 1 * 256 + h * 64, 2304 + 1 * 256 + h * 64, rowf, fixf, vl, lane);
    }
    {
        load_q(qf, H + qrow + 768 + h * 64, lane);
        const int kb = 16 * i0 - 64, t_lo = kb < 0 ? (-kb) / 32 : 0, t_hi = min(20, (T - kb) / 32);
        const LAS float* tab = (const LAS float*)(lds + TB0_OFF) + h * TB0_N + 576 - 64 - r16 - 16 * qi + 4 * hi;
        auto rowf = [&](int t, int kvi) -> const bf16* { return H + (size_t)(sb + kb + 32 * t + kvi) * EVEN_IN; };
        auto fixf = [&](int t, f32x16& s) {
#pragma unroll
            for (int r = 0; r < 16; ++r) s[r] = s[r] * QSC + tab[32 * t + (r & 3) + 8 * (r >> 2)]; };
        attn_run(st, qf, t_lo, t_hi, 1536 + h * 64, 2304 + h * 64, rowf, fixf, vl, lane);
    }
    attn_store(st, H + qrow + 3584 + h * 64, Y + (size_t)(sb + qpos) * EVEN_OUT + 512 + h * 64, lane);
}
__device__ __forceinline__ void odd_tables(LAS unsigned char* lds, const float* rpb, int tid) {
    LAS float* tc = (LAS float*)lds;
    for (int e = tid; e < 8 * 465; e += 512) tc[e] = rpb[e] * L2E;
}
__device__ __forceinline__ void mixC_task(const bf16* H, bf16* Y, int T, LAS unsigned char* lds, LAS unsigned char* vl, int qt, int h, int lane) {
    const int tok0 = qt * 32, pos0 = tok0 % T, sb = tok0 - pos0, gr = pos0 >> 6, c0 = pos0 & 63, rows = T >> 6, qi = lane & 31, hi = lane >> 5;
    const int sr = min(max(gr - 4, 0), rows - 8), kc0 = c0 ? 24 : 0, qc = c0 + qi, sc = min(max(qc - 8, 0), 48);
    bf16x8 qf[4]; load_q(qf, H + (size_t)(tok0 + qi) * ODD_IN + h * 64, lane);
    AttnSt st; st.m = -1e30f; st.l = 0.f;
#pragma unroll
    for (int r = 0; r < 16; ++r) { st.o0[r] = 0.f; st.o1[r] = 0.f; }
    const LAS float* tab = (const LAS float*)lds + h * 465 + (sr - gr + 7) * 31 + 15 - qc;
    auto rowf = [&](int t, int kvi) -> const bf16* { const int e = 32 * t + kvi, kr = (e * 205) >> 13, kc = e - 40 * kr; return H + (size_t)(sb + (sr + kr) * 64 + kc0 + kc) * ODD_IN; };
    auto fixf = [&](int t, f32x16& s) {
#pragma unroll
        for (int r = 0; r < 16; ++r) { const int e = 32 * t + (r & 3) + 8 * (r >> 2) + 4 * hi, kr = (e * 205) >> 13, kc = kc0 + e - 40 * kr;
            const bool ok = (unsigned)(kc - sc) < 16u; const int dc = min(max(kc - qc, -15), 15) + qc;
            const float v = s[r] * QSC + tab[kr * 31 + dc]; s[r] = ok ? v : -INFINITY; }
    };
    attn_run(st, qf, 0, 10, 512 + h * 64, 1024 + h * 64, rowf, fixf, vl, lane);
    attn_store(st, H + (size_t)(tok0 + qi) * ODD_IN + 3584 + h * 64, Y + (size_t)(tok0 + qi) * ODD_OUT + h * 64, lane);
}
constexpr int PARAM_OFF = LDSCTL_OFF + 512;
enum { P_XP = 0, P_XS, P_T5, P_WIE, P_SINK, P_WOE, P_WIO, P_RPB, P_LBD, P_GN, P_WOO, P_LNG, P_LNB, P_OUT, P_WS, NPARAM };
template <class Tp> __device__ __forceinline__ Tp* ldp(LAS unsigned char* lds, int i) {
    volatile LAS unsigned* PB = (volatile LAS unsigned*)(lds + PARAM_OFF);
    const unsigned lo = __builtin_amdgcn_readfirstlane(PB[2 * i]), hi = __builtin_amdgcn_readfirstlane(PB[2 * i + 1]);
    return (Tp*)(((unsigned long long)hi << 32) | lo);
}
struct Ctx { int tid, lane, wave, bid, G, gtid, gstride, gw, NGW; };
__device__ __forceinline__ Ctx mkctx() {
    Ctx c; int t = threadIdx.x; asm volatile("" : "+v"(t));
    c.tid = t; c.lane = t & 63; c.wave = __builtin_amdgcn_readfirstlane(t >> 6); c.bid = blockIdx.x; c.G = gridDim.x;
    c.gtid = c.bid * (NWAVES * 64) + t; c.gstride = c.G * NWAVES * 64; c.gw = c.bid * NWAVES + c.wave; c.NGW = c.G * NWAVES; return c;
}
struct Chunk { int row0, T, nseq; bool is_p; };
__device__ __forceinline__ Chunk mkchunk(int c) { Chunk k; k.row0 = c * MC; k.is_p = k.row0 < NP_TOK; k.T = k.is_p ? T_P : T_S; k.nseq = MC / k.T; return k; }
__device__ __forceinline__ const float* chunk_x(LAS unsigned char* lds, const Chunk& k) {
    return k.is_p ? ldp<const float>(lds, P_XP) + (size_t)k.row0 * DM : ldp<const float>(lds, P_XS) + (size_t)(k.row0 - NP_TOK) * DM; }
__device__ __forceinline__ void grid_bar(LAS unsigned char* lds) {
    XcdBarrier b; b.bar = (unsigned*)(ldp<unsigned char>(lds, P_WS) + WS_CTL) + CW_BAR; b.x = xb_xcc_id(); b.st = (volatile LAS unsigned*)(lds + MISC_OFF) + 8;
    xcd_barrier(b);
}

__device__ __forceinline__ void ph_weights(LAS unsigned char* lds) {
    const Ctx x = mkctx(); unsigned char* ws = ldp<unsigned char>(lds, P_WS);
    LAS float* scr = (LAS float*)(lds + x.wave * 16384);
    constexpr int I1 = (DM / 64) * (EVEN_IN / 32), I2 = (EVEN_OUT / 64) * (DM / 32), I3 = (DM / 64) * (ODD_IN / 32), I4 = (ODD_OUT / 64) * (DM / 32);
    for (int it = x.gw; it < I1 + I2 + I3 + I4; it += x.NGW) {
        int r = it;
        if (r < I1) { p0_transpose_item(ldp<const float>(lds, P_WIE), DM, EVEN_IN, (bf16*)(ws + WS_W1), scr, r, x.lane); continue; } r -= I1;
        if (r < I2) { p0_transpose_item(ldp<const float>(lds, P_WOE), EVEN_OUT, DM, (bf16*)(ws + WS_W2), scr, r, x.lane); continue; } r -= I2;
        if (r < I3) { p0_transpose_item(ldp<const float>(lds, P_WIO), DM, ODD_IN, (bf16*)(ws + WS_W3), scr, r, x.lane); continue; } r -= I3;
        p0_transpose_item(ldp<const float>(lds, P_WOO), ODD_OUT, DM, (bf16*)(ws + WS_W4), scr, r, x.lane);
    }
}
__device__ __forceinline__ void ph_convert(LAS unsigned char* lds, int c) {
    const Ctx x = mkctx(); const Chunk k = mkchunk(c); const float* xin = chunk_x(lds, k); bf16* XB = (bf16*)(ldp<unsigned char>(lds, P_WS) + WS_XB);
    for (int i = x.gtid; i < MC * DM / 8; i += x.gstride) { const f32x4 a = ((const GAS f32x4*)xin)[2 * i], b = ((const GAS f32x4*)xin)[2 * i + 1];
        v4u w; w.x = pk2(a.x, a.y); w.y = pk2(a.z, a.w); w.z = pk2(b.x, b.y); w.w = pk2(b.z, b.w); ((GAS v4u*)XB)[i] = w; }
}
template <int WOFF, int N> __device__ __forceinline__ void ph_gemm_in(LAS unsigned char* lds) {
    unsigned char* ws = ldp<unsigned char>(lds, P_WS);
    pg8::Gemm g{(const pg8::bf16_t*)(ws + WS_XB), (const pg8::bf16_t*)(ws + WOFF), MC, N, DM}; pg8::StaticOrder S; S.init(MC, N, (int)gridDim.x, (int)blockIdx.x);
    pg8::EpiBf16<0> E{(pg8::bf16_t*)(ws + WS_H), N, nullptr, 0, 0, 1.f};
    pg8::gemm_phase<pg8::EpiBf16<0>, pg8::StaticOrder, true, true>(lds, g, S, E);
}
template <int WOFF, int K> __device__ __forceinline__ void ph_gemm_out(LAS unsigned char* lds, const float* base) {
    unsigned char* ws = ldp<unsigned char>(lds, P_WS);
    pg8::Gemm g{(const pg8::bf16_t*)(ws + WS_Y), (const pg8::bf16_t*)(ws + WOFF), MC, DM, K}; pg8::StaticOrder S; S.init(MC, DM, (int)gridDim.x, (int)blockIdx.x);
    EpiResF32 E{base, (float*)(ws + WS_Z), DM, ALPHA};
    pg8::gemm_phase<EpiResF32, pg8::StaticOrder, true, true>(lds, g, S, E);
}
__device__ __forceinline__ void ph_ln(LAS unsigned char* lds, int c, int layer, bool to_bf16) {
    const Ctx x = mkctx(); const Chunk k = mkchunk(c); unsigned char* ws = ldp<unsigned char>(lds, P_WS);
    const float* Z = (const float*)(ws + WS_Z); float* outc = ldp<float>(lds, P_OUT) + (size_t)k.row0 * DM; bf16* XB = (bf16*)(ws + WS_XB);
    const float* g = ldp<const float>(lds, P_LNG) + layer * DM; const float* b = ldp<const float>(lds, P_LNB) + layer * DM;
    for (int m = x.gw; m < MC; m += x.NGW) ln_row(Z + (size_t)m * DM, g, b, outc + (size_t)m * DM, to_bf16 ? XB + (size_t)m * DM : nullptr, x.lane);
}
__device__ __forceinline__ void ph_even_mix(LAS unsigned char* lds, int c) {
    const Ctx x = mkctx(); const Chunk k = mkchunk(c); unsigned char* ws = ldp<unsigned char>(lds, P_WS);
#if NAIVE_EVEN
    naive_even((const bf16*)(ws + WS_H), (bf16*)(ws + WS_Y), k.T, ldp<const float>(lds, P_T5), ldp<const float>(lds, P_SINK), x.gtid, x.gstride);
#else
    const bf16* H = (const bf16*)(ws + WS_H); bf16* Y = (bf16*)(ws + WS_Y);
    even_tables(lds, ldp<const float>(lds, P_T5), x.tid);
    __syncthreads();
    LAS unsigned char* vl = lds + VT_OFF + x.wave * 4096;
    const float* sink = ldp<const float>(lds, P_SINK);
    for (int it = x.gw; it < (MC / 32) * 4; it += x.NGW) mixB_task(H, Y, k.T, lds, vl, it >> 2, it & 3, x.lane);
    for (int it = x.gw; it < (MC / 32) * 8; it += x.NGW) mixA_task(H, Y, k.T, sink, lds, vl, it >> 3, it & 7, x.lane);
    __syncthreads();
#endif
}
__device__ __forceinline__ void ph_odd_mix(LAS unsigned char* lds, int c) {
    const Ctx x = mkctx(); const Chunk k = mkchunk(c); unsigned char* ws = ldp<unsigned char>(lds, P_WS);
#if NAIVE_NA
    naive_na((const bf16*)(ws + WS_H), (bf16*)(ws + WS_Y), k.T, ldp<const float>(lds, P_RPB), x.gtid, x.gstride);
#else
    { const bf16* H = (const bf16*)(ws + WS_H); bf16* Y = (bf16*)(ws + WS_Y);
      odd_tables(lds, ldp<const float>(lds, P_RPB), x.tid);
      __syncthreads();
      LAS unsigned char* vl = lds + VT_OFF + x.wave * 4096;
      for (int it = x.gw; it < (MC / 32) * 8; it += x.NGW) mixC_task(H, Y, k.T, lds, vl, it >> 3, it & 7, x.lane);
      __syncthreads(); }
#endif
    naive_hgrn((const bf16*)(ws + WS_H), (float*)(ws + WS_O), k.T, k.nseq, ldp<const float>(lds, P_LBD), lds, x.tid, x.bid, x.G);
}
__device__ __forceinline__ void ph_odd_combine(LAS unsigned char* lds) {
    const Ctx x = mkctx(); unsigned char* ws = ldp<unsigned char>(lds, P_WS);
    hgrn_combine((const bf16*)(ws + WS_H), (const float*)(ws + WS_O), (bf16*)(ws + WS_Y), ldp<const float>(lds, P_GN), x.gw, x.NGW, x.lane);
}

struct Args { const float* in[13]; float* out; unsigned char* ws; int pad0, pad1; };
__global__ void __launch_bounds__(NWAVES * 64, 2) mk_fwd(Args args) {
    extern __shared__ __attribute__((aligned(16))) unsigned char lds_raw[];
    LAS unsigned char* lds = (LAS unsigned char*)lds_raw;
    for (int u = threadIdx.x; u < (LDS_BYTES - LDSCTL_OFF) / 4; u += NWAVES * 64) ((LAS unsigned*)(lds + LDSCTL_OFF))[u] = 0u;
    __syncthreads();
    if (threadIdx.x == 0) { volatile LAS unsigned* PB = (volatile LAS unsigned*)(lds + PARAM_OFF);
#pragma unroll
        for (int i = 0; i < 13; ++i) { const unsigned long long p = (unsigned long long)args.in[i]; PB[2 * i] = (unsigned)p; PB[2 * i + 1] = (unsigned)(p >> 32); }
        { const unsigned long long p = (unsigned long long)args.out; PB[2 * P_OUT] = (unsigned)p; PB[2 * P_OUT + 1] = (unsigned)(p >> 32); }
        { const unsigned long long p = (unsigned long long)args.ws; PB[2 * P_WS] = (unsigned)p; PB[2 * P_WS + 1] = (unsigned)(p >> 32); } }
    __syncthreads();
    (void)xcd_barrier_post((unsigned*)(ldp<unsigned char>(lds, P_WS) + WS_CTL) + CW_BAR, (volatile LAS unsigned*)(lds + MISC_OFF) + 8);

    ph_weights(lds);
    for (int c = 0; c < NCH; ++c) {
        ph_convert(lds, c);                       grid_bar(lds);
        ph_gemm_in<(int)WS_W1, EVEN_IN>(lds);      grid_bar(lds);
        ph_even_mix(lds, c);                      grid_bar(lds);
        { const Chunk k = mkchunk(c); ph_gemm_out<(int)WS_W2, EVEN_OUT>(lds, chunk_x(lds, k)); }   grid_bar(lds);
        ph_ln(lds, c, 0, true);                   grid_bar(lds);
        ph_gemm_in<(int)WS_W3, ODD_IN>(lds);       grid_bar(lds);
        ph_odd_mix(lds, c);                       grid_bar(lds);
        ph_odd_combine(lds);                      grid_bar(lds);
        { const Chunk k = mkchunk(c); ph_gemm_out<(int)WS_W4, ODD_OUT>(lds, ldp<const float>(lds, P_OUT) + (size_t)k.row0 * DM); }   grid_bar(lds);
        ph_ln(lds, c, 1, false);                  grid_bar(lds);
    }
}

extern "C" void kernel_launch(void* const* d_in, const int* in_sizes, int n_in, void* d_out, int out_size, void* d_ws, size_t ws_size, hipStream_t stream) {
    static int grid = 0;
    if (grid == 0) {
        if (n_in != 13 || out_size != NTOK * DM || ws_size < WS_END) { fprintf(stderr, "kernel_launch: unexpected shapes (n_in %d out %d ws %zu)\n", n_in, out_size, ws_size); grid = -1; return; }
        int dev = 0, cus = 0, per_cu = 0;
        (void)hipGetDevice(&dev); (void)hipDeviceGetAttribute(&cus, hipDeviceAttributeMultiprocessorCount, dev);
        (void)hipFuncSetAttribute((const void*)mk_fwd, hipFuncAttributeMaxDynamicSharedMemorySize, LDS_BYTES);
        (void)hipOccupancyMaxActiveBlocksPerMultiprocessor(&per_cu, (const void*)mk_fwd, NWAVES * 64, LDS_BYTES);
        (void)hipGetLastError();
        if (per_cu < 1) { fprintf(stderr, "kernel_launch: occupancy query says %d blocks per CU\n", per_cu); }
        grid = cus;
    }
    if (grid < 0) return;
    (void)hipMemsetAsync((char*)d_ws + WS_CTL, 0, CTL_ZERO_BYTES, stream);
    Args a{};
    for (int i = 0; i < 13; ++i) a.in[i] = (const float*)d_in[i];
    a.out = (float*)d_out; a.ws = (unsigned char*)d_ws;
    void* kargs[] = {&a};
    hipError_t e = hipLaunchCooperativeKernel((const void*)mk_fwd, dim3(grid), dim3(NWAVES * 64), kargs, LDS_BYTES, stream);
    if (e != hipSuccess) fprintf(stderr, "kernel_launch: cooperative launch failed: %s (grid %d)\n", hipGetErrorString(e), grid);
}
```

```cpp
#define NAIVE_EVEN 0
#define NAIVE_NA 0
#define NAIVE_HGRN 0
#include <hip/hip_runtime.h>
#include <cstdio>
#include <cstdint>
namespace pg8 {
#define PG8_LAS __attribute__((address_space(3)))
typedef unsigned short bf16_t;
typedef short bf16x8 __attribute__((ext_vector_type(8)));
typedef float f32x4 __attribute__((ext_vector_type(4)));
typedef unsigned u32x4 __attribute__((ext_vector_type(4)));
constexpr int BM = 256, BK = 64, HALF = 128, HTB = HALF * BK * 2  , STAGE_BYTES = 8 * HTB, NXCD = 8, WGM = 8;

__host__ __device__ __forceinline__ int lds_byte(int r, int c) { const int st = (r >> 4) * 2 + (c >> 5), rr = r & 15, cc = c & 31, ob = rr * 64 + cc * 2; return st * 1024 + (ob ^ (((ob >> 9) & 1) << 5)); }
__host__ __device__ __forceinline__ void stage_rc(int b, int& R, int& C) { const int st = b / 1024, sb = b % 1024, swz = sb ^ (((sb >> 9) & 1) << 5); R = (st >> 1) * 16 + swz / 64; C = (st & 1) * 32 + (swz % 64) / 2; }
__host__ __device__ __forceinline__ int perm32(int rho) { const int n = rho >> 4, i = rho & 15; return 8 * (i >> 2) + 4 * n + (i & 3); }

struct Unit { int pm, pn; };
struct Gemm { const bf16_t* A; const bf16_t* Bt; int M, N, K; };

struct StaticOrder {
    int nM, nN, nwg, G, c;
    __host__ __device__ void init(int M, int N, int G_, int c_) { nM = M / BM; nN = N / BM; nwg = nM * nN; G = G_; c = c_; }
    __host__ __device__ bool next(int i, Unit& u) const {
        const long L = (long)i * G + c; if (L >= nwg) return false;
        int wgid = (int)L; { const int q = nwg / NXCD, r = nwg % NXCD, xcd = wgid % NXCD, off = wgid / NXCD; wgid = (xcd < r ? xcd * (q + 1) : r * (q + 1) + (xcd - r) * q) + off; }
        const int nig = WGM * nN, gid = wgid / nig, fm = gid * WGM, gsz = (nM - fm) < WGM ? (nM - fm) : WGM;
        u.pm = fm + ((wgid % nig) % gsz); u.pn = (wgid % nig) / gsz; return true;
    }
    __device__ __forceinline__ void a_ready(const Unit&) const {}
    __device__ __forceinline__ void done(const Unit&) const {}
};

__device__ __forceinline__ unsigned cvt_pk_bf16(float lo, float hi) { unsigned r; asm volatile("v_cvt_pk_bf16_f32 %0, %1, %2" : "=v"(r) : "v"(lo), "v"(hi)); return r; }
typedef float f32x2 __attribute__((ext_vector_type(2)));
__device__ __forceinline__ f32x2 gelu_pk(f32x2 v) {
    const f32x2 av = __builtin_elementwise_abs(v), d = av * 0.2316418882f + 1.0f;
    f32x2 t; t.x = __builtin_amdgcn_rcpf(d.x); t.y = __builtin_amdgcn_rcpf(d.y);
    f32x2 q = t * 0.5307027145f + (-0.7265760135f); q = q * t + 0.7107068705f; q = q * t + (-0.142248368f); q = q * t + 0.127414796f; q = q * t;
    const f32x2 s = (v * v) * (-0.72134752044f);
    f32x2 e; e.x = __builtin_amdgcn_exp2f(s.x); e.y = __builtin_amdgcn_exp2f(s.y);
    const f32x2 m = v * (q * e), r = v - m;
    f32x2 o; o.x = v.x < 0.f ? m.x : r.x; o.y = v.y < 0.f ? m.y : r.y; return o;
}

template <int ACT  > struct EpiBf16 {
    static constexpr bool PERM = true, AFTER_DRAIN = false; static_assert(ACT == 0 || ACT == 1, "EpiBf16: ACT is 0 (none) or 1 (gelu_pk)");
    bf16_t* O; int ldc; const float* bias; int split_cols; size_t split_stride; float scale0;
    __device__ __forceinline__ void operator()(const f32x4 (&acc)[2][2][4][2], const Unit& u, int wr, int wc, int fr, int fq) const {
        const int row0 = u.pm * BM + wr * 64 + fr; int colt = u.pn * BM; bf16_t* base = O;
        float sc = 1.f; if (split_cols) { const int t = colt / split_cols; base += (size_t)t * split_stride; colt -= t * split_cols; if (t == 0) sc = scale0; }
        const int col0 = colt + wc * 32 + 8 * fq, bcol0 = u.pn * BM + wc * 32 + 8 * fq;
        f32x4 bv[2][2];
#pragma unroll
        for (int bj = 0; bj < 2; ++bj)
#pragma unroll
            for (int n = 0; n < 2; ++n) bv[bj][n] = bias ? *(const f32x4*)(bias + bcol0 + bj * HALF + 4 * n) : (f32x4){0.f, 0.f, 0.f, 0.f};
#pragma unroll
        for (int ai = 0; ai < 2; ++ai)
#pragma unroll
            for (int m = 0; m < 4; ++m) { bf16_t* rowp = base + (size_t)(row0 + ai * HALF + m * 16) * ldc + col0;
#pragma unroll
                for (int bj = 0; bj < 2; ++bj) { f32x4 v0 = acc[ai][bj][m][0] + bv[bj][0], v1 = acc[ai][bj][m][1] + bv[bj][1];
                    if (ACT == 1) { f32x2 a = gelu_pk((f32x2){v0[0], v0[1]}), b = gelu_pk((f32x2){v0[2], v0[3]}), c = gelu_pk((f32x2){v1[0], v1[1]}), d = gelu_pk((f32x2){v1[2], v1[3]});
                        v0 = (f32x4){a.x, a.y, b.x, b.y}; v1 = (f32x4){c.x, c.y, d.x, d.y}; }
                    v0 = v0 * sc; v1 = v1 * sc; u32x4 w; w.x = cvt_pk_bf16(v0[0], v0[1]); w.y = cvt_pk_bf16(v0[2], v0[3]); w.z = cvt_pk_bf16(v1[0], v1[1]); w.w = cvt_pk_bf16(v1[2], v1[3]);
                    *(u32x4*)(rowp + bj * HALF) = w; } }
    }
};

struct PanelStats {
    unsigned* xbuf;
    unsigned* cnt;
    unsigned* tmo;
    int ntn; float eps;
    unsigned code;
    __device__ __forceinline__ bool run(const f32x4 (&v)[2][2][4][2], const Unit& u, int wr, int wc, int fr, int fq, PG8_LAS unsigned char* lds, int wid, int lane) const {
        typedef float f32x2v __attribute__((ext_vector_type(2)));
        PG8_LAS f32x2v* P = (PG8_LAS f32x2v*)lds;
        PG8_LAS f32x2v* S = (PG8_LAS f32x2v*)(lds + 8192);
        PG8_LAS unsigned* flag = (PG8_LAS unsigned*)(lds + 8192 + 2048);
#pragma unroll
        for (int ai = 0; ai < 2; ++ai)
#pragma unroll
            for (int m = 0; m < 4; ++m) {
                float s = 0.f;
#pragma unroll
                for (int bj = 0; bj < 2; ++bj)
#pragma unroll
                    for (int n = 0; n < 2; ++n) { const f32x4 x = v[ai][bj][m][n]; s += (x[0] + x[1]) + (x[2] + x[3]); }
                s += __shfl_xor(s, 16); s += __shfl_xor(s, 32);
                const float mw = s * (1.0f / 64.0f); float q = 0.f;
#pragma unroll
                for (int bj = 0; bj < 2; ++bj)
#pragma unroll
                    for (int n = 0; n < 2; ++n) { const f32x4 d = v[ai][bj][m][n] - mw; q += (d[0] * d[0] + d[1] * d[1]) + (d[2] * d[2] + d[3] * d[3]); }
                q += __shfl_xor(q, 16); q += __shfl_xor(q, 32);
                if (fq == 0) P[(ai * HALF + wr * 64 + m * 16 + fr) * 4 + wc] = (f32x2v){mw, q};
            }
        asm volatile("s_waitcnt lgkmcnt(0)" ::: "memory"); __builtin_amdgcn_s_barrier(); asm volatile("" ::: "memory");
#if defined(BROKEN_EXCHANGE_NO_WAIT)
#warning BROKEN CONTROL BUILD: the row-statistics exchange does not wait; results are wrong by design
        if (blockIdx.x >= 64) { const long long t0_ = clock64(); while (clock64() - t0_ < 60000) __builtin_amdgcn_s_sleep(8); }
#endif
        const int row = wid * 32 + (lane & 31);
        if (lane < 32) {
            const f32x2v a = P[row * 4 + 0], b = P[row * 4 + 1], c = P[row * 4 + 2], d = P[row * 4 + 3];
            const float mt = (a.x + b.x + c.x + d.x) * 0.25f;
            const float da = a.x - mt, db = b.x - mt, dc = c.x - mt, dd = d.x - mt;
            const float m2 = (a.y + b.y) + (c.y + d.y) + 64.0f * ((da * da + db * db) + (dc * dc + dd * dd));
            unsigned long long* slot = (unsigned long long*)xbuf + ((size_t)(u.pm * BM + row) * 4 + u.pn);
            __hip_atomic_store(slot, ((unsigned long long)__float_as_uint(m2) << 32) | __float_as_uint(mt), __ATOMIC_RELAXED, __HIP_MEMORY_SCOPE_AGENT);
        }
        asm volatile("s_waitcnt vmcnt(0)" ::: "memory");
        if (lane == 0) __hip_atomic_fetch_add(cnt + 64 * u.pm, 1u, __ATOMIC_RELAXED, __HIP_MEMORY_SCOPE_AGENT);
        if (wid == 0) {
            bool dead = false; const unsigned long long t0 = __builtin_amdgcn_s_memrealtime(); const unsigned want = 8u * (unsigned)ntn;
            for (;;) {
#if defined(BROKEN_EXCHANGE_NO_WAIT)
                break;
#endif
                if ((unsigned)__builtin_amdgcn_readfirstlane(__hip_atomic_load(cnt + 64 * u.pm, __ATOMIC_RELAXED, __HIP_MEMORY_SCOPE_AGENT)) >= want) break;
                if (__builtin_amdgcn_s_memrealtime() - t0 > 2000000ull) {
                    if (lane == 0) { unsigned expect = 0u; __hip_atomic_compare_exchange_strong(tmo + 1, &expect, code | (unsigned)(u.pm & 0xff), __ATOMIC_RELAXED, __ATOMIC_RELAXED, __HIP_MEMORY_SCOPE_AGENT);
                                     __hip_atomic_store(tmo, 1u, __ATOMIC_RELAXED, __HIP_MEMORY_SCOPE_AGENT); }
                    dead = true; break; }
                __builtin_amdgcn_s_sleep(2);
            }
            __builtin_amdgcn_fence(__ATOMIC_ACQUIRE, "agent");
            if (lane == 0) flag[0] = dead ? 1u : 0u;
        }
        asm volatile("s_waitcnt vmcnt(0) lgkmcnt(0)" ::: "memory"); __builtin_amdgcn_s_barrier(); asm volatile("" ::: "memory");
        const bool bad = flag[0] != 0u;
        if (lane < 32) {
            const unsigned long long* slot = (const unsigned long long*)xbuf + (size_t)(u.pm * BM + row) * 4; float mt[4], m2[4]; float ms = 0.f;
#pragma unroll
            for (int t = 0; t < 4; ++t) { if (t < ntn) { const unsigned long long w = __hip_atomic_load(slot + t, __ATOMIC_RELAXED, __HIP_MEMORY_SCOPE_AGENT); mt[t] = __uint_as_float((unsigned)w); m2[t] = __uint_as_float((unsigned)(w >> 32)); } else { mt[t] = 0.f; m2[t] = 0.f; } ms += mt[t]; }
            const float mean = ms / (float)ntn; float q = 0.f;
#pragma unroll
            for (int t = 0; t < 4; ++t) if (t < ntn) { const float dm = mt[t] - mean; q += m2[t] + 256.0f * dm * dm; }
            S[row] = (f32x2v){mean, 1.0f / sqrtf(q / (256.0f * (float)ntn) + eps)};
        }
        asm volatile("s_waitcnt lgkmcnt(0)" ::: "memory"); __builtin_amdgcn_s_barrier(); asm volatile("" ::: "memory");
        return bad;
    }
};
struct EpiLnRes {
    static constexpr bool PERM = false, AFTER_DRAIN = true;
    const float* base; float* out; int ldc; const float* bias; PanelStats st; unsigned poison;
    __device__ __forceinline__ void fused(f32x4 (&acc)[2][2][4][2], const Unit& u, int wr, int wc, int fr, int fq, PG8_LAS unsigned char* lds, int wid, int lane) const {
        typedef float f32x2v __attribute__((ext_vector_type(2)));
        const PG8_LAS f32x2v* S = (const PG8_LAS f32x2v*)(lds + 8192);
        const int col0 = u.pn * BM + wc * 32 + 4 * fq;
#pragma unroll
        for (int bj = 0; bj < 2; ++bj)
#pragma unroll
            for (int n = 0; n < 2; ++n) { const f32x4 bv = bias ? *(const f32x4*)(bias + col0 + bj * HALF + n * 16) : (f32x4){0.f, 0.f, 0.f, 0.f};
#pragma unroll
                for (int ai = 0; ai < 2; ++ai)
#pragma unroll
                    for (int m = 0; m < 4; ++m) acc[ai][bj][m][n] += bv; }
        f32x4 pre[4][2][2];
#pragma unroll
        for (int m = 0; m < 4; ++m) { const size_t off = (size_t)(u.pm * BM + wr * 64 + m * 16 + fr) * ldc + col0;
#pragma unroll
            for (int bj = 0; bj < 2; ++bj)
#pragma unroll
                for (int n = 0; n < 2; ++n) pre[m][bj][n] = *(const f32x4*)(base + off + bj * HALF + n * 16); }
        const bool bad = st.run(acc, u, wr, wc, fr, fq, lds, wid, lane) || poison != 0u;
        const float qnan = __builtin_nanf("");
#pragma unroll
        for (int ai = 0; ai < 2; ++ai)
#pragma unroll
            for (int m = 0; m < 4; ++m) { const int r = ai * HALF + wr * 64 + m * 16 + fr; const f32x2v sr = S[r]; const size_t off = (size_t)(u.pm * BM + r) * ldc + col0;
#pragma unroll
                for (int bj = 0; bj < 2; ++bj)
#pragma unroll
                    for (int n = 0; n < 2; ++n) { const f32x4 bs = ai == 0 ? pre[m][bj][n] : *(const f32x4*)(base + off + bj * HALF + n * 16); f32x4 o = bs + (acc[ai][bj][m][n] - sr.x) * sr.y;
                        if (bad) o = (f32x4){qnan, qnan, qnan, qnan}; *(f32x4*)(out + off + bj * HALF + n * 16) = o; }
                if (m & 1) asm volatile("" ::: "memory"); }
    }
};
struct EpiLnResLn {
    static constexpr bool PERM = false, AFTER_DRAIN = true;
    const float* base; float* out; bf16_t* xn; int ldc; const float* bias; PanelStats st1, st2; unsigned poison;
    __device__ __forceinline__ void fused(f32x4 (&acc)[2][2][4][2], const Unit& u, int wr, int wc, int fr, int fq, PG8_LAS unsigned char* lds, int wid, int lane) const {
        typedef float f32x2v __attribute__((ext_vector_type(2))); typedef unsigned u32x2v __attribute__((ext_vector_type(2)));
        const PG8_LAS f32x2v* S = (const PG8_LAS f32x2v*)(lds + 8192);
        const int col0 = u.pn * BM + wc * 32 + 4 * fq;
#pragma unroll
        for (int bj = 0; bj < 2; ++bj)
#pragma unroll
            for (int n = 0; n < 2; ++n) { const f32x4 bv = bias ? *(const f32x4*)(bias + col0 + bj * HALF + n * 16) : (f32x4){0.f, 0.f, 0.f, 0.f};
#pragma unroll
                for (int ai = 0; ai < 2; ++ai)
#pragma unroll
                    for (int m = 0; m < 4; ++m) acc[ai][bj][m][n] += bv; }
        bool bad = st1.run(acc, u, wr, wc, fr, fq, lds, wid, lane) || poison != 0u;
        const float qnan = __builtin_nanf("");
#pragma unroll
        for (int ai = 0; ai < 2; ++ai)
#pragma unroll
            for (int m = 0; m < 4; ++m) { const int r = ai * HALF + wr * 64 + m * 16 + fr; const f32x2v sr = S[r]; const size_t off = (size_t)(u.pm * BM + r) * ldc + col0;
#pragma unroll
                for (int bj = 0; bj < 2; ++bj)
#pragma unroll
                    for (int n = 0; n < 2; ++n) { const f32x4 bs = *(const f32x4*)(base + off + bj * HALF + n * 16); acc[ai][bj][m][n] = bs + (acc[ai][bj][m][n] - sr.x) * sr.y; }
                asm volatile("" : "+v"(acc[ai][0][m][0]), "+v"(acc[ai][0][m][1]), "+v"(acc[ai][1][m][0]), "+v"(acc[ai][1][m][1]));
                if (m & 1) asm volatile("" ::: "memory"); }
        const bool bad1 = bad;
        bad = st2.run(acc, u, wr, wc, fr, fq, lds, wid, lane) || bad;
#pragma unroll
        for (int ai = 0; ai < 2; ++ai)
#pragma unroll
            for (int m = 0; m < 4; ++m) { const int r = ai * HALF + wr * 64 + m * 16 + fr; const f32x2v sr = S[r]; const size_t off = (size_t)(u.pm * BM + r) * ldc + col0;
#pragma unroll
                for (int bj = 0; bj < 2; ++bj)
#pragma unroll
                    for (int n = 0; n < 2; ++n) { const f32x4 x1 = acc[ai][bj][m][n]; *(f32x4*)(out + off + bj * HALF + n * 16) = bad1 ? (f32x4){qnan, qnan, qnan, qnan} : x1;
                        const f32x4 o = (x1 - sr.x) * sr.y; u32x2v w; w.x = cvt_pk_bf16(o[0], o[1]); w.y = cvt_pk_bf16(o[2], o[3]);
                        if (bad) { w.x = 0x7fc07fc0u; w.y = 0x7fc07fc0u; } *(u32x2v*)(xn + off + bj * HALF + n * 16) = w; }
                asm volatile("" ::: "memory"); }
    }
};

template <class Epi, class Sched, bool ALIGN_EPI = false, bool SP2 = false>
__device__ __forceinline__ void gemm_phase(PG8_LAS unsigned char* lds, const Gemm g, const Sched& S, const Epi& E) {
    int tid_ = threadIdx.x; asm volatile("" : "+v"(tid_));
    const int tid = tid_, wid = __builtin_amdgcn_readfirstlane(tid >> 6), lane = tid & 63, wr = wid >> 2, wc = wid & 3, fr = lane & 15, fq = lane >> 4;
    const int K = g.K, nt = K / BK;
    unsigned voffA[2], voffB[2];
#pragma unroll
    for (int i = 0; i < 2; ++i) { int R, C; stage_rc(tid * 16 + i * 8192, R, C); const int Rb = Epi::PERM ? ((R & ~31) + perm32(R & 31)) : R;
        voffA[i] = (unsigned)(R * K + C) * 2u; voffB[i] = (unsigned)(Rb * K + C) * 2u; }
    const size_t kstep = (size_t)(BK * 2);
    const size_t hstep = (size_t)HALF * K * 2;
    const size_t tstep = 2 * hstep;
    const unsigned ldsw = (unsigned)wid * 1024u;
    const int aoff = lds_byte(wr * 64 + fr, fq * 8), boff = lds_byte(wc * 32 + fr, fq * 8);
#define PG8_SA(b, h) (((b) * 2 + (h)) * HTB)
#define PG8_SB(b, h) ((4 + (b) * 2 + (h)) * HTB)
#define PG8_STAGE(bufoff, gbase, voff) do { _Pragma("unroll") for (int _i = 0; _i < 2; ++_i) \
        __builtin_amdgcn_global_load_lds((const unsigned*)((const char*)(gbase) + (voff)[_i]), (PG8_LAS unsigned*)(lds + (bufoff) + ldsw + _i * 8192), 16, 0, 0); } while (0)
#define PG8_LDA(dst, b, h) do { _Pragma("unroll") for (int m = 0; m < 4; ++m) _Pragma("unroll") for (int k = 0; k < 2; ++k) dst[m][k] = *(const PG8_LAS bf16x8*)(lds + PG8_SA(b, h) + aoff + m * 2048 + k * 1024); } while (0)
#define PG8_LDB(dst, b, h) do { _Pragma("unroll") for (int n = 0; n < 2; ++n) _Pragma("unroll") for (int k = 0; k < 2; ++k) dst[n][k] = *(const PG8_LAS bf16x8*)(lds + PG8_SB(b, h) + boff + n * 2048 + k * 1024); } while (0)
#define PG8_MMA(ai, bj, At, Bt) do { __builtin_amdgcn_s_setprio(1); _Pragma("unroll") for (int m = 0; m < 4; ++m) _Pragma("unroll") for (int n = 0; n < 2; ++n) _Pragma("unroll") for (int k = 0; k < 2; ++k) \
        acc[ai][bj][m][n] = __builtin_amdgcn_mfma_f32_16x16x32_bf16(Bt[n][k], At[m][k], acc[ai][bj][m][n], 0, 0, 0); __builtin_amdgcn_s_setprio(0); } while (0)
#define PG8_WAIT_V(n) asm volatile("s_waitcnt vmcnt(" #n ")" ::: "memory")
#define PG8_WAIT_L(n) asm volatile("s_waitcnt lgkmcnt(" #n ")" ::: "memory")
#define PG8_BAR __builtin_amdgcn_s_barrier()
#define PG8_SCHED __builtin_amdgcn_sched_barrier(0)
    Unit cur, nxt; int ui = 0;
    if (!S.next(0, cur)) return;
    f32x4 acc[2][2][4][2];
#pragma unroll
    for (int a = 0; a < 2; ++a)
#pragma unroll
        for (int b = 0; b < 2; ++b)
#pragma unroll
            for (int m = 0; m < 4; ++m)
#pragma unroll
                for (int n = 0; n < 2; ++n) acc[a][b][m][n] = (f32x4){0.f, 0.f, 0.f, 0.f};
    bf16x8 At[4][2], B0[2][2], B1[2][2];
    const char* cA = (const char*)g.A + (size_t)cur.pm * tstep; const char* cB = (const char*)g.Bt + (size_t)cur.pn * tstep;
    S.a_ready(cur);
    if constexpr (SP2) {
        PG8_STAGE(PG8_SB(0, 0), cB, voffB); PG8_STAGE(PG8_SB(0, 1), cB + hstep, voffB); PG8_STAGE(PG8_SA(0, 0), cA, voffA); PG8_STAGE(PG8_SA(0, 1), cA + hstep, voffA);
        if (wr == 1) PG8_BAR;
        PG8_WAIT_V(2); PG8_BAR;
        PG8_STAGE(PG8_SB(1, 0), cB + kstep, voffB); PG8_STAGE(PG8_SA(1, 0), cA + kstep, voffA); PG8_STAGE(PG8_SB(1, 1), cB + hstep + kstep, voffB);
        PG8_WAIT_V(6); PG8_BAR;
    } else {
        PG8_STAGE(PG8_SB(0, 0), cB, voffB); PG8_STAGE(PG8_SA(0, 0), cA, voffA); PG8_STAGE(PG8_SB(0, 1), cB + hstep, voffB); PG8_STAGE(PG8_SA(0, 1), cA + hstep, voffA);
        if (wr == 1) PG8_BAR;
        PG8_WAIT_V(4); PG8_BAR;
        PG8_STAGE(PG8_SB(1, 0), cB + kstep, voffB); PG8_STAGE(PG8_SA(1, 0), cA + kstep, voffA); PG8_STAGE(PG8_SB(1, 1), cB + hstep + kstep, voffB);
        PG8_WAIT_V(6); PG8_BAR;
    }
    for (;;) {
        const bool has_next = S.next(ui + 1, nxt);
        const char* nA = has_next ? (const char*)g.A + (size_t)nxt.pm * tstep : cA; const char* nB = has_next ? (const char*)g.Bt + (size_t)nxt.pn * tstep : cB;
        for (int t = 0; t < nt; t += 2) {
            const bool last = (t == nt - 2);
            const char* a1 = cA + (size_t)(t + 1) * kstep;
            const char* a2 = last ? nA : cA + (size_t)(t + 2) * kstep; const char* b2 = last ? nB : cB + (size_t)(t + 2) * kstep;
            const char* a3 = a2 + kstep; const char* b3 = b2 + kstep;
            if (last && has_next) S.a_ready(nxt);
            if constexpr (SP2) {
            PG8_LDB(B0, 0, 0); PG8_LDB(B1, 0, 1); PG8_SCHED; PG8_LDA(At, 0, 0); PG8_STAGE(PG8_SA(1, 1), a1 + hstep, voffA);
            PG8_WAIT_V(8); PG8_WAIT_L(0); PG8_BAR; PG8_MMA(0, 0, At, B0); PG8_MMA(0, 1, At, B1); PG8_BAR; PG8_SCHED;
            PG8_LDA(At, 0, 1); PG8_STAGE(PG8_SB(0, 0), b2, voffB); PG8_STAGE(PG8_SB(0, 1), b2 + hstep, voffB); PG8_STAGE(PG8_SA(0, 0), a2, voffA);
            PG8_WAIT_V(8); PG8_WAIT_L(0); PG8_BAR; PG8_MMA(1, 0, At, B0); PG8_MMA(1, 1, At, B1); PG8_BAR; PG8_SCHED;
            PG8_LDB(B0, 1, 0); PG8_LDB(B1, 1, 1); PG8_SCHED; PG8_LDA(At, 1, 0); PG8_STAGE(PG8_SA(0, 1), a2 + hstep, voffA);
            PG8_WAIT_V(8); PG8_WAIT_L(0); PG8_BAR; PG8_MMA(0, 0, At, B0); PG8_MMA(0, 1, At, B1); PG8_BAR; PG8_SCHED;
            PG8_LDA(At, 1, 1); PG8_STAGE(PG8_SB(1, 0), b3, voffB); PG8_STAGE(PG8_SB(1, 1), b3 + hstep, voffB); PG8_STAGE(PG8_SA(1, 0), a3, voffA);
            PG8_WAIT_V(8); PG8_WAIT_L(0); PG8_BAR; PG8_MMA(1, 0, At, B0); PG8_MMA(1, 1, At, B1); PG8_BAR; PG8_SCHED;
            } else {
            PG8_LDB(B0, 0, 0); PG8_SCHED; PG8_LDA(At, 0, 0); PG8_STAGE(PG8_SA(1, 1), a1 + hstep, voffA);
            PG8_WAIT_L(8); PG8_BAR; PG8_WAIT_L(0); PG8_MMA(0, 0, At, B0); PG8_BAR; PG8_SCHED;
            PG8_LDB(B1, 0, 1); PG8_STAGE(PG8_SB(0, 0), b2, voffB);
            PG8_BAR; PG8_WAIT_L(0); PG8_MMA(0, 1, At, B1); PG8_BAR;
            PG8_LDA(At, 0, 1); PG8_STAGE(PG8_SA(0, 0), a2, voffA);
            PG8_BAR; PG8_WAIT_L(0); PG8_MMA(1, 0, At, B0); PG8_BAR; PG8_SCHED;
            PG8_STAGE(PG8_SB(0, 1), b2 + hstep, voffB);
            PG8_WAIT_V(6); PG8_BAR; PG8_MMA(1, 1, At, B1); PG8_BAR;
            PG8_LDB(B0, 1, 0); PG8_SCHED; PG8_LDA(At, 1, 0); PG8_STAGE(PG8_SA(0, 1), a2 + hstep, voffA);
            PG8_WAIT_L(8); PG8_BAR; PG8_WAIT_L(0); PG8_MMA(0, 0, At, B0); PG8_BAR; PG8_SCHED;
            PG8_LDB(B1, 1, 1); PG8_STAGE(PG8_SB(1, 0), b3, voffB);
            PG8_BAR; PG8_WAIT_L(0); PG8_MMA(0, 1, At, B1); PG8_BAR;
            PG8_LDA(At, 1, 1); PG8_STAGE(PG8_SA(1, 0), a3, voffA);
            PG8_BAR; PG8_WAIT_L(0); PG8_MMA(1, 0, At, B0); PG8_BAR; PG8_SCHED;
            PG8_STAGE(PG8_SB(1, 1), b3 + hstep, voffB);
            PG8_WAIT_V(6); PG8_BAR; PG8_MMA(1, 1, At, B1); PG8_BAR;
            }
        }
        if constexpr (ALIGN_EPI) { if (wr == 0) PG8_BAR; }
        if constexpr (!Epi::AFTER_DRAIN) { E(acc, cur, wr, wc, fr, fq); S.done(cur); }
        if (!has_next) break;
#pragma unroll
        for (int a = 0; a < 2; ++a)
#pragma unroll
            for (int b = 0; b < 2; ++b)
#pragma unroll
                for (int m = 0; m < 4; ++m)
#pragma unroll
                    for (int n = 0; n < 2; ++n) acc[a][b][m][n] = (f32x4){0.f, 0.f, 0.f, 0.f};
        cur = nxt; cA = nA; cB = nB; ++ui;
        if constexpr (ALIGN_EPI) { if (wr == 1) PG8_BAR; }
    }
    PG8_WAIT_V(0);
    if constexpr (!ALIGN_EPI) { if (wr == 0) PG8_BAR; }
    PG8_BAR;
    if constexpr (Epi::AFTER_DRAIN) { E.fused(acc, cur, wr, wc, fr, fq, lds, wid, lane); S.done(cur); }
#undef PG8_SA
#undef PG8_SB
#undef PG8_STAGE
#undef PG8_LDA
#undef PG8_LDB
#undef PG8_MMA
#undef PG8_WAIT_V
#undef PG8_WAIT_L
#undef PG8_BAR
#undef PG8_SCHED
}
}
#define GAS __attribute__((address_space(1)))
#define LAS __attribute__((address_space(3)))
typedef unsigned short bf16;
typedef unsigned v4u __attribute__((ext_vector_type(4)));
typedef float f32x4 __attribute__((ext_vector_type(4)));
typedef short bf16x8 __attribute__((ext_vector_type(8)));
typedef GAS unsigned gu32;
typedef GAS unsigned long long gu64;
#define RLX_AGENT __ATOMIC_RELAXED, __HIP_MEMORY_SCOPE_AGENT
#define LDS_WAIT() asm volatile("s_waitcnt lgkmcnt(0)" ::: "memory")
#define VM_WAIT() asm volatile("s_waitcnt vmcnt(0)" ::: "memory")
__device__ __forceinline__ unsigned long long rt() { return __builtin_amdgcn_s_memrealtime(); }
__device__ __forceinline__ unsigned f2bf(float f) { unsigned u = __builtin_bit_cast(unsigned, f); return (u + 0x7fffu + ((u >> 16) & 1u)) >> 16; }
__device__ __forceinline__ unsigned pk2(float lo, float hi) { return f2bf(lo) | (f2bf(hi) << 16); }

#define XB_TMO      128
#define XB_XCNT(j)  (256  + 64 * (j))
#define XB_XSUB(j)  (1280 + 64 * (j))
#define XB_XGEN(j)  (2304 + 64 * (j))
#define XB_TOP      3328
#define XB_TOPGEN   3392
#define XCD_BAR_WORDS 3456
#define XB_SPIN_CAP (1u << 18)

__device__ __forceinline__ unsigned xb_ld(unsigned* p)              { return __hip_atomic_load(p, __ATOMIC_RELAXED, __HIP_MEMORY_SCOPE_AGENT); }
__device__ __forceinline__ unsigned xb_add(unsigned* p, unsigned v) { return __hip_atomic_fetch_add(p, v, __ATOMIC_RELAXED, __HIP_MEMORY_SCOPE_AGENT); }
__device__ __forceinline__ unsigned xb_xcc_id() { return (unsigned)__builtin_amdgcn_s_getreg((3 << 11) | 20) & 0xFu; }
#define XB_SPIN(cond, bar) do { unsigned _sp = 0; while (cond) { __builtin_amdgcn_s_sleep(1); \
    if ((++_sp & 255u) == 0u) { if (xb_ld(&(bar)[XB_TMO])) break; if (_sp > XB_SPIN_CAP) { atomicAdd(&(bar)[XB_TMO], 1u); break; } } } } while (0)

struct XcdBarrier {
    unsigned* bar; unsigned x;
    volatile LAS unsigned* st;
};

__device__ __forceinline__ XcdBarrier xcd_barrier_post(unsigned* bar, volatile LAS unsigned* st) {
    XcdBarrier b; b.bar = bar; b.x = xb_xcc_id(); b.st = st;
    if (threadIdx.x == 0) (void)xb_add(&bar[XB_XCNT(b.x)], 1u);
    return b;
}
__device__ __forceinline__ void xcd_barrier_complete(unsigned* bar, unsigned x, unsigned& nloc, unsigned& nx) {
    const unsigned G = gridDim.x * gridDim.y * gridDim.z;
    unsigned sum, cnt, mine, sp = 0u;
    for (;;) {
        sum = 0u; cnt = 0u; mine = 0u;
#pragma unroll
        for (unsigned j = 0; j < 16; ++j) { const unsigned c = xb_ld(&bar[XB_XCNT(j)]); sum += c; cnt += (c > 0u) ? 1u : 0u; mine = (j == x) ? c : mine; }
        if (sum == G) break;
        __builtin_amdgcn_s_sleep(1);
        if ((++sp & 255u) == 0u) { if (xb_ld(&bar[XB_TMO])) break; if (sp > XB_SPIN_CAP) { atomicAdd(&bar[XB_TMO], 1u); break; } }
    }
    nloc = mine > 0u ? mine : 1u; nx = cnt > 0u ? cnt : 1u;
}

__device__ __forceinline__ void xcd_barrier(const XcdBarrier& b) {
    asm volatile("s_waitcnt vmcnt(0)" ::: "memory");
    __syncthreads();
    if (threadIdx.x == 0) {
        unsigned* bar = b.bar;
        __builtin_amdgcn_s_waitcnt(0);
        unsigned nloc = b.st[0], nx = b.st[1];
        if (nloc == 0u) { xcd_barrier_complete(bar, b.x, nloc, nx); b.st[0] = nloc; b.st[1] = nx; }
        const unsigned old = xb_add(&bar[XB_XSUB(b.x)], 1u);
        const unsigned gen = old / nloc;
        if (old + 1u == (gen + 1u) * nloc) {
            __builtin_amdgcn_fence(__ATOMIC_RELEASE, "agent");
            asm volatile("s_waitcnt vmcnt(0)" ::: "memory");
            const unsigned og = xb_add(&bar[XB_TOP], 1u);
            const unsigned tg = og / nx;
            if (og + 1u == (tg + 1u) * nx) xb_add(&bar[XB_TOPGEN], 1u);
            else XB_SPIN(xb_ld(&bar[XB_TOPGEN]) == tg, bar);
            __builtin_amdgcn_fence(__ATOMIC_ACQUIRE, "agent");
            xb_add(&bar[XB_XGEN(b.x)], 1u);
            asm volatile("s_waitcnt vmcnt(0)" ::: "memory");
        } else {
            XB_SPIN(xb_ld(&bar[XB_XGEN(b.x)]) == gen, bar);
            __builtin_amdgcn_fence(__ATOMIC_ACQUIRE, "agent");
            asm volatile("s_waitcnt vmcnt(0)" ::: "memory");
        }
    }
    __syncthreads();
}

constexpr int NWAVES = 8;
constexpr int DM = 1024;
constexpr int NP_TOK = 16 * 4096, NS_TOK = 2 * 16384, NTOK = NP_TOK + NS_TOK;
constexpr int T_P = 4096, T_S = 16384;
constexpr int MC = 32768, NCH = NTOK / MC;
constexpr int EVEN_IN = 3840, EVEN_OUT = 768, ODD_IN = 4608, ODD_OUT = 1024;
constexpr float ALPHA = 1.4142135623730951f;
constexpr float LN_EPS = 1e-5f, RMS_EPS = 1e-6f;

constexpr size_t MiB = 1u << 20;
constexpr size_t WS_CTL = 0, CTL_ZERO_BYTES = 1 * MiB;
constexpr size_t WS_W1 = 2 * MiB;
constexpr size_t WS_W2 = 10 * MiB;
constexpr size_t WS_W3 = 12 * MiB;
constexpr size_t WS_W4 = 22 * MiB;
constexpr size_t WS_XB = 32 * MiB;
constexpr size_t WS_H  = 96 * MiB;
constexpr size_t WS_Y  = 384 * MiB;
constexpr size_t WS_Z  = 448 * MiB;
constexpr size_t WS_O  = 576 * MiB;
constexpr size_t WS_SLOC = 704 * MiB;
constexpr size_t WS_SINIT = 736 * MiB;
constexpr size_t WS_DTOT = 768 * MiB;
constexpr size_t WS_END = 770 * MiB;
constexpr int CW_BAR = 4096;

constexpr int RING_BYTES = 131072;
constexpr int LDSCTL_OFF = RING_BYTES, MISC_OFF = LDSCTL_OFF + 320;
constexpr int LDS_BYTES = 147456;

__device__ __forceinline__ float bf2f(unsigned short b) { return __builtin_bit_cast(float, (unsigned)b << 16); }
__device__ __forceinline__ float bflo(unsigned u) { return __builtin_bit_cast(float, u << 16); }
__device__ __forceinline__ float bfhi(unsigned u) { return __builtin_bit_cast(float, u & 0xffff0000u); }
__device__ __forceinline__ float sigmoidf_(float x) { return 1.f / (1.f + __expf(-x)); }
__device__ __forceinline__ float siluf_(float x) { return x / (1.f + __expf(-x)); }

__device__ __forceinline__ int t5_bucket(int rel) {
    const int n = rel < 0 ? -rel : rel;
    int b = n < 8 ? n : n < 15 ? 8 : n < 27 ? 9 : n < 50 ? 10 : n < 91 ? 11 : n < 166 ? 12 : n < 305 ? 13 : n < 559 ? 14 : 15;
    return b + (rel > 0 ? 16 : 0);
}

__device__ __forceinline__ float wave_sum(float v) {
#pragma unroll
    for (int o = 1; o < 64; o <<= 1) v += __shfl_xor(v, o);
    return v;
}

__device__ __forceinline__ void p0_transpose_item(const float* W, int K, int N, bf16* WT, LAS float* scr, int item, int lane) {
    const int nblk = N / 32, kb = item / nblk, nb = item % nblk, k0 = 64 * kb, n0 = 32 * nb;
#pragma unroll 8
    for (int i = 0; i < 32; ++i) { const int kk = 2 * i + (lane >> 5); scr[kk * 33 + (lane & 31)] = W[(size_t)(k0 + kk) * N + n0 + (lane & 31)]; }
    LDS_WAIT(); asm volatile("" ::: "memory");
    const int c = lane & 7;
#pragma unroll
    for (int j = 0; j < 4; ++j) { const int n = (lane >> 3) + 8 * j; const LAS float* s = scr + (8 * c) * 33 + n;
        v4u o; o.x = pk2(s[0 * 33], s[1 * 33]); o.y = pk2(s[2 * 33], s[3 * 33]); o.z = pk2(s[4 * 33], s[5 * 33]); o.w = pk2(s[6 * 33], s[7 * 33]);
        *(GAS v4u*)(WT + (size_t)(n0 + n) * K + k0 + 8 * c) = o; }
    LDS_WAIT(); asm volatile("" ::: "memory");
}

struct EpiResF32 {
    static constexpr bool PERM = false, AFTER_DRAIN = false;
    const float* base; float* out; int ldc; float alpha;
    __device__ __forceinline__ void operator()(const pg8::f32x4 (&acc)[2][2][4][2], const pg8::Unit& u, int wr, int wc, int fr, int fq) const {
        const int col0 = u.pn * pg8::BM + wc * 32 + 4 * fq;
#pragma unroll
        for (int ai = 0; ai < 2; ++ai)
#pragma unroll
            for (int m = 0; m < 4; ++m) { const size_t off = (size_t)(u.pm * pg8::BM + ai * pg8::HALF + wr * 64 + m * 16 + fr) * ldc + col0;
#pragma unroll
                for (int bj = 0; bj < 2; ++bj)
#pragma unroll
                    for (int n = 0; n < 2; ++n) { const pg8::f32x4 bs = *(const pg8::f32x4*)(base + off + bj * pg8::HALF + n * 16);
                        *(pg8::f32x4*)(out + off + bj * pg8::HALF + n * 16) = bs * alpha + acc[ai][bj][m][n]; }
                asm volatile("" ::: "memory"); }
    }
};

__device__ __forceinline__ void load_row64(const bf16* p, float (&x)[64], float scale) {
#pragma unroll
    for (int c = 0; c < 8; ++c) { const v4u w = *(const GAS v4u*)(p + c * 8);
        x[c * 8 + 0] = bflo(w.x) * scale; x[c * 8 + 1] = bfhi(w.x) * scale; x[c * 8 + 2] = bflo(w.y) * scale; x[c * 8 + 3] = bfhi(w.y) * scale;
        x[c * 8 + 4] = bflo(w.z) * scale; x[c * 8 + 5] = bfhi(w.z) * scale; x[c * 8 + 6] = bflo(w.w) * scale; x[c * 8 + 7] = bfhi(w.w) * scale; }
}
__device__ __forceinline__ void attend(const bf16* krow, const bf16* vrow, const float (&q)[64], float bias, float& m, float& l, float (&o)[64]) {
    float dot = 0.f;
#pragma unroll
    for (int c = 0; c < 8; ++c) { const v4u w = *(const GAS v4u*)(krow + c * 8);
        dot += q[c * 8 + 0] * bflo(w.x) + q[c * 8 + 1] * bfhi(w.x) + q[c * 8 + 2] * bflo(w.y) + q[c * 8 + 3] * bfhi(w.y)
             + q[c * 8 + 4] * bflo(w.z) + q[c * 8 + 5] * bfhi(w.z) + q[c * 8 + 6] * bflo(w.w) + q[c * 8 + 7] * bfhi(w.w); }
    const float s = dot + bias, mn = fmaxf(m, s), a = __expf(m - mn), p = __expf(s - mn);
    l = l * a + p; m = mn;
#pragma unroll
    for (int c = 0; c < 8; ++c) { const v4u w = *(const GAS v4u*)(vrow + c * 8);
        o[c * 8 + 0] = o[c * 8 + 0] * a + p * bflo(w.x); o[c * 8 + 1] = o[c * 8 + 1] * a + p * bfhi(w.x);
        o[c * 8 + 2] = o[c * 8 + 2] * a + p * bflo(w.y); o[c * 8 + 3] = o[c * 8 + 3] * a + p * bfhi(w.y);
        o[c * 8 + 4] = o[c * 8 + 4] * a + p * bflo(w.z); o[c * 8 + 5] = o[c * 8 + 5] * a + p * bfhi(w.z);
        o[c * 8 + 6] = o[c * 8 + 6] * a + p * bflo(w.w); o[c * 8 + 7] = o[c * 8 + 7] * a + p * bfhi(w.w); }
}
__device__ __forceinline__ void gate_store64(const float (&o)[64], float l, const bf16* gate, bf16* y) {
    const float rl = 1.f / l;
#pragma unroll
    for (int c = 0; c < 8; ++c) { const v4u g = *(const GAS v4u*)(gate + c * 8); v4u w;
        w.x = pk2(o[c * 8 + 0] * rl * siluf_(bflo(g.x)), o[c * 8 + 1] * rl * siluf_(bfhi(g.x)));
        w.y = pk2(o[c * 8 + 2] * rl * siluf_(bflo(g.y)), o[c * 8 + 3] * rl * siluf_(bfhi(g.y)));
        w.z = pk2(o[c * 8 + 4] * rl * siluf_(bflo(g.z)), o[c * 8 + 5] * rl * siluf_(bfhi(g.z)));
        w.w = pk2(o[c * 8 + 6] * rl * siluf_(bflo(g.w)), o[c * 8 + 7] * rl * siluf_(bfhi(g.w)));
        *(GAS v4u*)(y + c * 8) = w; }
}

__device__ __forceinline__ void naive_even(const bf16* H, bf16* Y, int T, const float* t5, const float* sink, int gtid, int gstride) {
    for (int it = gtid; it < MC * 12; it += gstride) {
        const int hh = it / MC, tok = it - hh * MC, pos = tok % T, sb = tok - pos;
        float q[64], o[64], m, l;
#pragma unroll
        for (int d = 0; d < 64; ++d) o[d] = 0.f;
        const bf16* hrow = H + (size_t)tok * EVEN_IN;
        if (hh < 8) {
            load_row64(hrow + hh * 64, q, 0.125f);
            m = sink[hh]; l = 1.f;
            const int kvh = hh >> 2;
            for (int rel = -128; rel <= 128; ++rel) { const int kp = pos + rel; if (kp < 0 || kp >= T) continue;
                const bf16* kr = H + (size_t)(sb + kp) * EVEN_IN;
                attend(kr + 512 + kvh * 64, kr + 640 + kvh * 64, q, t5[t5_bucket(rel) * 20 + hh], m, l, o); }
            gate_store64(o, l, hrow + 3072 + hh * 64, Y + (size_t)tok * EVEN_OUT + hh * 64);
        } else {
            const int h = hh - 8; m = -INFINITY; l = 0.f;
            for (int g = 0; g < 3; ++g) { const int dil = g == 0 ? 1 : g == 1 ? 4 : 16;
                load_row64(hrow + 768 + g * 256 + h * 64, q, 0.125f);
                for (int j = -64; j <= 64; ++j) { const int kp = pos + dil * j; if (kp < 0 || kp >= T) continue;
                    const bf16* kr = H + (size_t)(sb + kp) * EVEN_IN;
                    attend(kr + 1536 + g * 256 + h * 64, kr + 2304 + g * 256 + h * 64, q, t5[t5_bucket(dil * j) * 20 + 8 + g * 4 + h], m, l, o); } }
            gate_store64(o, l, hrow + 3584 + h * 64, Y + (size_t)tok * EVEN_OUT + 512 + h * 64);
        }
    }
}
__device__ __forceinline__ void naive_na(const bf16* H, bf16* Y, int T, const float* rpb, int gtid, int gstride) {
    const int rows = T / 64;
    for (int it = gtid; it < MC * 8; it += gstride) {
        const int h = it / MC, tok = it - h * MC, pos = tok % T, sb = tok - pos, r = pos >> 6, c = pos & 63;
        const int sr = min(max(r - 4, 0), rows - 8), sc = min(max(c - 8, 0), 48);
        float q[64], o[64], m = -INFINITY, l = 0.f;
#pragma unroll
        for (int d = 0; d < 64; ++d) o[d] = 0.f;
        const bf16* hrow = H + (size_t)tok * ODD_IN;
        load_row64(hrow + h * 64, q, 0.125f);
        for (int kr = sr; kr < sr + 8; ++kr)
            for (int kc = sc; kc < sc + 16; ++kc) { const bf16* krow = H + (size_t)(sb + kr * 64 + kc) * ODD_IN;
                attend(krow + 512 + h * 64, krow + 1024 + h * 64, q, rpb[(h * 15 + (kr - r + 7)) * 31 + (kc - c + 15)], m, l, o); }
        gate_store64(o, l, hrow + 3584 + h * 64, Y + (size_t)tok * ODD_OUT + h * 64);
    }
}
__device__ __forceinline__ void naive_hgrn(const bf16* H, float* O, int T, int nseq, const float* lb_d, LAS unsigned char* lds, int tid, int bid, int G) {
    LAS float* Fs = (LAS float*)lds; LAS float* Qs = Fs + 32 * 128; LAS float* Vs = Qs + 32 * 128; LAS float* Op = Vs + 32 * 128;
    const int dkg = tid >> 7, dv = tid & 127;
    for (int ch = bid; ch < nseq * 8; ch += G) {
        const int seq = ch >> 3, dir = (ch >> 2) & 1, head = ch & 3;
        float S[32];
#pragma unroll
        for (int i = 0; i < 32; ++i) S[i] = 0.f;
        const int zcol = 2560 + dir * 512 + head * 128;
        for (int t0 = 0; t0 < T; t0 += 32) {
            for (int e = tid; e < 32 * 128; e += 512) { const int tt = e >> 7, c = e & 127; const int t = t0 + tt, pos = dir ? T - 1 - t : t;
                const bf16* hr = H + (size_t)(seq * T + pos) * ODD_IN;
                const float a0 = lb_d[(dir * 2 + 0) * 512 + head * 128 + c], a1 = lb_d[(dir * 2 + 1) * 512 + head * 128 + c];
                const float lb = sigmoidf_(a1 - a0);
                Fs[e] = lb + (1.f - lb) * sigmoidf_(bf2f(hr[zcol + c])); Qs[e] = bf2f(hr[1536 + head * 128 + c]); Vs[e] = bf2f(hr[2048 + head * 128 + c]); }
            __syncthreads();
            for (int tt = 0; tt < 32; ++tt) { const float v = Vs[tt * 128 + dv]; float acc = 0.f;
#pragma unroll
                for (int i = 0; i < 32; ++i) { const float ff = Fs[tt * 128 + dkg * 32 + i]; S[i] = ff * S[i] + (1.f - ff) * v; acc += Qs[tt * 128 + dkg * 32 + i] * S[i]; }
                Op[(tt * 4 + dkg) * 128 + dv] = acc; }
            __syncthreads();
            for (int e = tid; e < 32 * 128; e += 512) { const int tt = e >> 7, c = e & 127; const int t = t0 + tt, pos = dir ? T - 1 - t : t;
                O[((size_t)dir * MC + seq * T + pos) * 512 + head * 128 + c] = (Op[(tt * 4 + 0) * 128 + c] + Op[(tt * 4 + 1) * 128 + c]) + (Op[(tt * 4 + 2) * 128 + c] + Op[(tt * 4 + 3) * 128 + c]); }
            __syncthreads();
        }
    }
}
__device__ __forceinline__ void hgrn_combine(const bf16* H, const float* O, bf16* Y, const float* gnorm, int gw, int NGW, int lane) {
    for (int it = gw; it < MC * 2; it += NGW) { const int tok = it >> 1, col = (it & 1) * 256 + lane * 4;
        const f32x4 a = *(const GAS f32x4*)(O + (size_t)tok * 512 + col), b = *(const GAS f32x4*)(O + ((size_t)MC + tok) * 512 + col);
        const f32x4 od = a + b; float ss = od.x * od.x + od.y * od.y + od.z * od.z + od.w * od.w;
#pragma unroll
        for (int o = 1; o < 32; o <<= 1) ss += __shfl_xor(ss, o);
        const float r = 1.f / sqrtf(ss * (1.f / 128.f) + RMS_EPS);
        const f32x4 gn = *(const GAS f32x4*)(gnorm + col);
        const unsigned long long gg = *(const GAS unsigned long long*)(H + (size_t)tok * ODD_IN + 4096 + col);
        const unsigned g0 = (unsigned)gg, g1 = (unsigned)(gg >> 32);
        const unsigned long long w = (unsigned long long)pk2(od.x * r * gn.x * siluf_(bflo(g0)), od.y * r * gn.y * siluf_(bfhi(g0)))
                                   | ((unsigned long long)pk2(od.z * r * gn.z * siluf_(bflo(g1)), od.w * r * gn.w * siluf_(bfhi(g1))) << 32);
        *(GAS unsigned long long*)(Y + (size_t)tok * ODD_OUT + 512 + col) = w; }
}
__device__ __forceinline__ void ln_row(const float* zrow, const float* g, const float* b, float* outf, bf16* outb, int lane) {
    const GAS f32x4* xr = (const GAS f32x4*)zrow + lane;
    f32x4 v[4]; float s = 0.f;
#pragma unroll
    for (int j = 0; j < 4; ++j) { v[j] = xr[64 * j]; s += (v[j].x + v[j].y) + (v[j].z + v[j].w); }
    const float mean = wave_sum(s) * (1.f / DM); float s2 = 0.f;
#pragma unroll
    for (int j = 0; j < 4; ++j) { v[j] = v[j] - mean; s2 += (v[j].x * v[j].x + v[j].y * v[j].y) + (v[j].z * v[j].z + v[j].w * v[j].w); }
    const float rstd = 1.f / sqrtf(wave_sum(s2) * (1.f / DM) + LN_EPS);
#pragma unroll
    for (int j = 0; j < 4; ++j) { const f32x4 gg = *((const GAS f32x4*)g + lane + 64 * j), bb = *((const GAS f32x4*)b + lane + 64 * j);
        const f32x4 o = v[j] * rstd * gg + bb;
        *((GAS f32x4*)outf + lane + 64 * j) = o;
        if (outb) *((GAS unsigned long long*)outb + lane + 64 * j) = (unsigned long long)pk2(o.x, o.y) | ((unsigned long long)pk2(o.z, o.w) << 32); }
}


typedef float f32x16 __attribute__((ext_vector_type(16)));
typedef short s16x4 __attribute__((ext_vector_type(4)));
typedef float f32x2_t __attribute__((ext_vector_type(2)));
typedef __bf16 bf16x2_t __attribute__((ext_vector_type(2)));
constexpr float L2E = 1.4426950408889634f, QSC = 0.125f * L2E;
__device__ __forceinline__ unsigned cvtpk(float lo, float hi) { f32x2_t v = {lo, hi}; bf16x2_t b = __builtin_convertvector(v, bf16x2_t); return __builtin_bit_cast(unsigned, b); }
__device__ __forceinline__ s16x4 vtr(LAS unsigned char* p) { return __builtin_bit_cast(s16x4, __builtin_amdgcn_ds_read_tr16_b64_v4i16((LAS s16x4*)p)); }
__device__ __forceinline__ float xhalf_max(float v) { auto rr = __builtin_amdgcn_permlane32_swap(__float_as_uint(v), __float_as_uint(v), false, false); return fmaxf(__uint_as_float(rr[0]), __uint_as_float(rr[1])); }
__device__ __forceinline__ float xhalf_sum(float v) { auto rr = __builtin_amdgcn_permlane32_swap(__float_as_uint(v), __float_as_uint(v), false, false); return __uint_as_float(rr[0]) + __uint_as_float(rr[1]); }
struct AttnSt { f32x16 o0, o1; float m, l; };

template <class RowF, class FixF>
__device__ __forceinline__ void attn_run(AttnSt& st, const bf16x8 (&qf)[4], int t_lo, int t_hi, int kcol, int vcol, RowF rowf, FixF fixf, LAS unsigned char* vl, int lane) {
    const int kvi = lane & 31, hi = lane >> 5;
    bf16x8 kn[4]; v4u vn[4];
#define ATT_LOAD(t_) do { const bf16* kr_ = rowf((t_), kvi) + kcol + 8 * hi; \
        _Pragma("unroll") for (int d0 = 0; d0 < 4; ++d0) kn[d0] = *(const GAS bf16x8*)(kr_ + d0 * 16); \
        _Pragma("unroll") for (int i = 0; i < 4; ++i) vn[i] = *(const GAS v4u*)(rowf((t_), i * 8 + (lane >> 3)) + vcol + (lane & 7) * 8); } while (0)
    if (t_lo < t_hi) ATT_LOAD(t_lo);
    LAS unsigned char* vw = vl + ((lane & 7) >> 2) * 2048 + (lane >> 3) * 64 + (lane & 3) * 16;
    LAS unsigned char* vr = vl + (4 * hi + ((lane & 15) >> 2)) * 64 + (16 * ((lane >> 4) & 1) + 4 * (lane & 3)) * 2;
    for (int t = t_lo; t < t_hi; ++t) {
        bf16x8 kf[4]; v4u vv[4];
#pragma unroll
        for (int i = 0; i < 4; ++i) { kf[i] = kn[i]; vv[i] = vn[i]; }
        if (t + 1 < t_hi) ATT_LOAD(t + 1);
#pragma unroll
        for (int i = 0; i < 4; ++i) *(LAS v4u*)(vw + i * 512) = vv[i];
        f32x16 s = {0.f, 0.f, 0.f, 0.f, 0.f, 0.f, 0.f, 0.f, 0.f, 0.f, 0.f, 0.f, 0.f, 0.f, 0.f, 0.f};
#pragma unroll
        for (int d0 = 0; d0 < 4; ++d0) s = __builtin_amdgcn_mfma_f32_32x32x16_bf16(kf[d0], qf[d0], s, 0, 0, 0);
        fixf(t, s);
        float mx = fmaxf(s[0], s[1]);
#pragma unroll
        for (int r = 2; r < 16; ++r) mx = fmaxf(mx, s[r]);
        mx = xhalf_max(mx);
        const float mn = fmaxf(st.m, mx), sc = __builtin_amdgcn_exp2f(st.m - mn);
        st.m = mn;
        float sum = 0.f;
#pragma unroll
        for (int r = 0; r < 16; ++r) { s[r] = __builtin_amdgcn_exp2f(s[r] - mn); sum += s[r]; }
        st.l = st.l * sc + sum;
        st.o0 = st.o0 * sc; st.o1 = st.o1 * sc;
        v4u p0, p1;
        p0.x = cvtpk(s[0], s[1]); p0.y = cvtpk(s[2], s[3]); p0.z = cvtpk(s[4], s[5]); p0.w = cvtpk(s[6], s[7]);
        p1.x = cvtpk(s[8], s[9]); p1.y = cvtpk(s[10], s[11]); p1.z = cvtpk(s[12], s[13]); p1.w = cvtpk(s[14], s[15]);
        const bf16x8 pf0 = __builtin_bit_cast(bf16x8, p0), pf1 = __builtin_bit_cast(bf16x8, p1);
        __builtin_amdgcn_wave_barrier();
#pragma unroll
        for (int d0 = 0; d0 < 2; ++d0) {
            const s16x4 a0 = vtr(vr + d0 * 2048), a1 = vtr(vr + d0 * 2048 + 512), b0 = vtr(vr + d0 * 2048 + 1024), b1 = vtr(vr + d0 * 2048 + 1536);
            const bf16x8 vf0 = (bf16x8){a0[0], a0[1], a0[2], a0[3], a1[0], a1[1], a1[2], a1[3]}, vf1 = (bf16x8){b0[0], b0[1], b0[2], b0[3], b1[0], b1[1], b1[2], b1[3]};
            if (d0 == 0) { st.o0 = __builtin_amdgcn_mfma_f32_32x32x16_bf16(vf0, pf0, st.o0, 0, 0, 0); st.o0 = __builtin_amdgcn_mfma_f32_32x32x16_bf16(vf1, pf1, st.o0, 0, 0, 0); }
            else         { st.o1 = __builtin_amdgcn_mfma_f32_32x32x16_bf16(vf0, pf0, st.o1, 0, 0, 0); st.o1 = __builtin_amdgcn_mfma_f32_32x32x16_bf16(vf1, pf1, st.o1, 0, 0, 0); }
        }
        __builtin_amdgcn_wave_barrier();
    }
#undef ATT_LOAD
}
__device__ __forceinline__ void attn_store(const AttnSt& st, const bf16* gate_row, bf16* y_row, int lane) {
    const int hi = lane >> 5; const float rl = 1.f / xhalf_sum(st.l);
#pragma unroll
    for (int d0 = 0; d0 < 2; ++d0)
#pragma unroll
        for (int g = 0; g < 4; ++g) { const int d = 32 * d0 + 8 * g + 4 * hi;
            const unsigned long long gg = *(const GAS unsigned long long*)(gate_row + d); const unsigned g0 = (unsigned)gg, g1 = (unsigned)(gg >> 32);
            const float a = (d0 ? st.o1[4 * g + 0] : st.o0[4 * g + 0]) * rl, b = (d0 ? st.o1[4 * g + 1] : st.o0[4 * g + 1]) * rl, c = (d0 ? st.o1[4 * g + 2] : st.o0[4 * g + 2]) * rl, e = (d0 ? st.o1[4 * g + 3] : st.o0[4 * g + 3]) * rl;
            *(GAS unsigned long long*)(y_row + d) = (unsigned long long)cvtpk(a * siluf_(bflo(g0)), b * siluf_(bfhi(g0))) | ((unsigned long long)cvtpk(c * siluf_(bflo(g1)), e * siluf_(bfhi(g1))) << 32); }
}
__device__ __forceinline__ void load_q(bf16x8 (&qf)[4], const bf16* qrow, int lane) {
#pragma unroll
    for (int d0 = 0; d0 < 4; ++d0) qf[d0] = *(const GAS bf16x8*)(qrow + d0 * 16 + 8 * (lane >> 5));
}
#define CROW(r, hi) (((r) & 3) + 8 * ((r) >> 2) + 4 * (hi))

constexpr int TA_OFF = 0, TA_N = 320;
constexpr int TB2_OFF = 10240, TB2_N = 192;
constexpr int TB1_OFF = 13312, TB1_N = 384;
constexpr int TB0_OFF = 19456, TB0_N = 1152;
constexpr int VT_OFF = 40960;
__device__ __forceinline__ void even_tables(LAS unsigned char* lds, const float* t5, int tid) {
    LAS float* ta = (LAS float*)(lds + TA_OFF); LAS float* tb2 = (LAS float*)(lds + TB2_OFF); LAS float* tb1 = (LAS float*)(lds + TB1_OFF); LAS float* tb0 = (LAS float*)(lds + TB0_OFF);
    for (int e = tid; e < 8 * TA_N; e += 512) { const int h = e / TA_N, rel = e % TA_N - 160; ta[e] = (rel >= -128 && rel <= 128) ? t5[t5_bucket(rel) * 20 + h] * L2E : -INFINITY; }
    for (int e = tid; e < 4 * TB2_N; e += 512) { const int h = e / TB2_N, rel = e % TB2_N - 96; tb2[e] = (rel >= -64 && rel <= 64) ? t5[t5_bucket(16 * rel) * 20 + 16 + h] * L2E : -INFINITY; }
    for (int e = tid; e < 4 * TB1_N; e += 512) { const int h = e / TB1_N, rel = e % TB1_N - 192; tb1[e] = (rel >= -64 && rel <= 64) ? t5[t5_bucket(4 * rel) * 20 + 12 + h] * L2E : -INFINITY; }
    for (int e = tid; e < 4 * TB0_N; e += 512) { const int h = e / TB0_N, rel = e % TB0_N - 576; tb0[e] = (rel >= -64 && rel <= 64) ? t5[t5_bucket(rel) * 20 + 8 + h] * L2E : -INFINITY; }
}
__device__ __forceinline__ void mixA_task(const bf16* H, bf16* Y, int T, const float* sink, LAS unsigned char* lds, LAS unsigned char* vl, int qt, int hh, int lane) {
    const int tok0 = qt * 32, pos0 = tok0 % T, sb = tok0 - pos0, qi = lane & 31, hi = lane >> 5, kvh = hh >> 2;
    bf16x8 qf[4]; load_q(qf, H + (size_t)(tok0 + qi) * EVEN_IN + hh * 64, lane);
    AttnSt st; st.m = sink[hh] * L2E; st.l = hi == 0 ? 1.f : 0.f;
#pragma unroll
    for (int r = 0; r < 16; ++r) { st.o0[r] = 0.f; st.o1[r] = 0.f; }
    const int t_lo = pos0 < 128 ? (128 - pos0) / 32 : 0, t_hi = min(9, (T - pos0 + 128) / 32);
    const LAS float* tab = (const LAS float*)(lds + TA_OFF) + hh * TA_N + 160 - 128 - qi + 4 * hi;
    auto rowf = [&](int t, int kvi) -> const bf16* { return H + (size_t)(sb + pos0 - 128 + 32 * t + kvi) * EVEN_IN; };
    auto fixf = [&](int t, f32x16& s) {
#pragma unroll
        for (int r = 0; r < 16; ++r) s[r] = s[r] * QSC + tab[32 * t + (r & 3) + 8 * (r >> 2)];
    };
    attn_run(st, qf, t_lo, t_hi, 512 + kvh * 64, 640 + kvh * 64, rowf, fixf, vl, lane);
    attn_store(st, H + (size_t)(tok0 + qi) * EVEN_IN + 3072 + hh * 64, Y + (size_t)(tok0 + qi) * EVEN_OUT + hh * 64, lane);
}
__device__ __forceinline__ void mixB_task(const bf16* H, bf16* Y, int T, LAS unsigned char* lds, LAS unsigned char* vl, int qt, int h, int lane) {
    const int per_seq = T / 32, seq = qt / per_seq, w = qt - seq * per_seq, r16 = w & 15, i0 = (w >> 4) * 32, sb = seq * T, qi = lane & 31, hi = lane >> 5;
    const int qpos = r16 + 16 * (i0 + qi); const size_t qrow = (size_t)(sb + qpos) * EVEN_IN;
    AttnSt st; st.m = -1e30f; st.l = 0.f;
#pragma unroll
    for (int r = 0; r < 16; ++r) { st.o0[r] = 0.f; st.o1[r] = 0.f; }
    bf16x8 qf[4];
    {
        load_q(qf, H + qrow + 768 + 2 * 256 + h * 64, lane);
        const int L = T / 16, kb = i0 - 64, t_lo = kb < 0 ? (-kb) / 32 : 0, t_hi = min(5, (L - kb) / 32);
        const LAS float* tab = (const LAS float*)(lds + TB2_OFF) + h * TB2_N + 96 - 64 - qi + 4 * hi;
        auto rowf = [&](int t, int kvi) -> const bf16* { return H + (size_t)(sb + r16 + 16 * (kb + 32 * t + kvi)) * EVEN_IN; };
        auto fixf = [&](int t, f32x16& s) {
#pragma unroll
            for (int r = 0; r < 16; ++r) s[r] = s[r] * QSC + tab[32 * t + (r & 3) + 8 * (r >> 2)]; };
        attn_run(st, qf, t_lo, t_hi, 1536 + 2 * 256 + h * 64, 2304 + 2 * 256 + h * 64, rowf, fixf, vl, lane);
    }
    {
        load_q(qf, H + qrow + 768 + 1 * 256 + h * 64, lane);
        const int L = T / 4, kb = 4 * i0 - 64, t_lo = kb < 0 ? (-kb) / 32 : 0, t_hi = min(8, (L - kb) / 32), r4 = r16 & 3;
        const LAS float* tab = (const LAS float*)(lds + TB1_OFF) + h * TB1_N + 192 - 64 - (r16 >> 2) - 4 * qi + 4 * hi;
        auto rowf = [&](int t, int kvi) -> const bf16* { return H + (size_t)(sb + r4 + 4 * (kb + 32 * t + kvi)) * EVEN_IN; };
        auto fixf = [&](int t, f32x16& s) {
#pragma unroll
            for (int r = 0; r < 16; ++r) s[r] = s[r] * QSC + tab[32 * t + (r & 3) + 8 * (r >> 2)]; };
        attn_run(st, qf, t_lo, t_hi, 1536 + 1 * 256 + h * 64, 2304 + 1 * 256 + h * 64, rowf, fixf, vl, lane);
    }
    {
        load_q(qf, H + qrow + 768 + h * 64, lane);
        const int kb = 16 * i0 - 64, t_lo = kb < 0 ? (-kb) / 32 : 0, t_hi = min(20, (T - kb) / 32);
        const LAS float* tab = (const LAS float*)(lds + TB0_OFF) + h * TB0_N + 576 - 64 - r16 - 16 * qi + 4 * hi;
        auto rowf = [&](int t, int kvi) -> const bf16* { return H + (size_t)(sb + kb + 32 * t + kvi) * EVEN_IN; };
        auto fixf = [&](int t, f32x16& s) {
#pragma unroll
            for (int r = 0; r < 16; ++r) s[r] = s[r] * QSC + tab[32 * t + (r & 3) + 8 * (r >> 2)]; };
        attn_run(st, qf, t_lo, t_hi, 1536 + h * 64, 2304 + h * 64, rowf, fixf, vl, lane);
    }
    attn_store(st, H + qrow + 3584 + h * 64, Y + (size_t)(sb + qpos) * EVEN_OUT + 512 + h * 64, lane);
}
__device__ __forceinline__ void odd_tables(LAS unsigned char* lds, const float* rpb, int tid) {
    LAS float* tc = (LAS float*)lds;
    for (int e = tid; e < 8 * 465; e += 512) tc[e] = rpb[e] * L2E;
}
__device__ __forceinline__ void mixC_task(const bf16* H, bf16* Y, int T, LAS unsigned char* lds, LAS unsigned char* vl, int qt, int h, int lane) {
    const int tok0 = qt * 32, pos0 = tok0 % T, sb = tok0 - pos0, gr = pos0 >> 6, c0 = pos0 & 63, rows = T >> 6, qi = lane & 31, hi = lane >> 5;
    const int sr = min(max(gr - 4, 0), rows - 8), kc0 = c0 ? 24 : 0, qc = c0 + qi, sc = min(max(qc - 8, 0), 48);
    bf16x8 qf[4]; load_q(qf, H + (size_t)(tok0 + qi) * ODD_IN + h * 64, lane);
    AttnSt st; st.m = -1e30f; st.l = 0.f;
#pragma unroll
    for (int r = 0; r < 16; ++r) { st.o0[r] = 0.f; st.o1[r] = 0.f; }
    const LAS float* tab = (const LAS float*)lds + h * 465 + (sr - gr + 7) * 31 + 15 - qc;
    auto rowf = [&](int t, int kvi) -> const bf16* { const int e = 32 * t + kvi, kr = (e * 205) >> 13, kc = e - 40 * kr; return H + (size_t)(sb + (sr + kr) * 64 + kc0 + kc) * ODD_IN; };
    auto fixf = [&](int t, f32x16& s) {
#pragma unroll
        for (int r = 0; r < 16; ++r) { const int e = 32 * t + (r & 3) + 8 * (r >> 2) + 4 * hi, kr = (e * 205) >> 13, kc = kc0 + e - 40 * kr;
            const bool ok = (unsigned)(kc - sc) < 16u; const int dc = min(max(kc - qc, -15), 15) + qc;
            const float v = s[r] * QSC + tab[kr * 31 + dc]; s[r] = ok ? v : -INFINITY; }
    };
    attn_run(st, qf, 0, 10, 512 + h * 64, 1024 + h * 64, rowf, fixf, vl, lane);
    attn_store(st, H + (size_t)(tok0 + qi) * ODD_IN + 3584 + h * 64, Y + (size_t)(tok0 + qi) * ODD_OUT + h * 64, lane);
}

constexpr int HG_RP = 272;
constexpr int HG_QI = 0, HG_KI = 64 * HG_RP, HG_VV = 2 * 64 * HG_RP, HG_EREF = 3 * 64 * HG_RP, HG_EEND = HG_EREF + 512, HG_DD = HG_EEND + 512, HG_TOT = HG_DD + 512, HG_REGION = HG_TOT + 1024;
static_assert(2 * HG_REGION <= RING_BYTES, "hgrn LDS");
constexpr int SEG = 512, SEGCH = SEG / 64;
template <int MODE>
__device__ __forceinline__ void hgrn_seg_task(const bf16* H, float* O, float* SLOC, const float* SINIT, float* DTOT, const float* lb_d, int T, LAS unsigned char* lds, int task, int tid) {
    const int hp = task & 1, dir = (task >> 1) & 1, sg = task >> 2, tokbase = sg * SEG;
    const int lane = tid & 63, w = __builtin_amdgcn_readfirstlane(tid >> 6);
    const int hd = tid >> 8, half = (tid >> 7) & 1, ch = tid & 127, headp = hp * 2 + hd;
    const float lb = sigmoidf_(lb_d[(dir * 2 + 1) * 512 + headp * 128 + ch] - lb_d[(dir * 2) * 512 + headp * 128 + ch]);
    const int zc = 2560 + dir * 512 + headp * 128 + ch, qc = 1536 + headp * 128 + ch, ic = 2048 + headp * 128 + ch;
    LAS unsigned char* P = lds + hd * HG_REGION;
    const int mhd = w >> 2, j = w & 3, mhead = hp * 2 + mhd, c31 = lane & 31, hi = lane >> 5;
    LAS unsigned char* R = lds + mhd * HG_REGION;
    const size_t sidx = (size_t)((sg * 2 + dir) * 4 + mhead) * 16384 + (size_t)(j * 4) * 1024 + lane;
    f32x16 S[4];
#pragma unroll
    for (int i = 0; i < 4; ++i)
#pragma unroll
        for (int r = 0; r < 16; ++r) S[i][r] = MODE ? SINIT[sidx + (i * 16 + r) * 64] : 0.f;
    float dtot = 1.f;
    const int trq = (lane & 15) >> 2, trc = (16 * ((lane >> 4) & 1) + 4 * (lane & 3)) * 2;
    for (int c = 0; c < SEGCH; ++c) {
        float bp[32], om[32], qv[32]; float run = 0.f;
#pragma unroll
        for (int tt = 0; tt < 32; ++tt) { const int tau = 32 * half + tt, u = c * 64 + tau, tok = tokbase + (dir ? SEG - 1 - u : u);
            const bf16* row = H + (size_t)tok * ODD_IN;
            const float f = lb + (1.f - lb) * sigmoidf_(bf2f(row[zc]));
            run += __logf(f); bp[tt] = run; om[tt] = 1.f - f; qv[tt] = bf2f(row[qc]);
            *(LAS bf16*)(P + HG_VV + tau * HG_RP + ch * 2) = row[ic]; }
        ((LAS float*)(P + HG_TOT))[half * 128 + ch] = run;
        __syncthreads();
        const float t0 = ((LAS float*)(P + HG_TOT))[ch], t1 = ((LAS float*)(P + HG_TOT))[128 + ch];
#pragma unroll
        for (int tt = 0; tt < 32; ++tt) { const int tau = 32 * half + tt; const float d = bp[tt] + (half ? t0 : 0.f) - t0;
            const float qi = qv[tt] * __expf(fminf(d, 80.f)), ki = om[tt] * __expf(fminf(-d, 80.f));
            *(LAS bf16*)(P + HG_QI + tau * HG_RP + ch * 2) = (bf16)f2bf(qi); *(LAS bf16*)(P + HG_KI + tau * HG_RP + ch * 2) = (bf16)f2bf(ki); }
        if (half == 0) { const float dd = __expf(t0 + t1); ((LAS float*)(P + HG_EREF))[ch] = __expf(t0); ((LAS float*)(P + HG_EEND))[ch] = __expf(t1); ((LAS float*)(P + HG_DD))[ch] = dd; dtot *= dd; }
        __syncthreads();
        if (MODE) {
            f32x16 ot0, ot1;
#pragma unroll
            for (int r = 0; r < 16; ++r) { ot0[r] = 0.f; ot1[r] = 0.f; }
#define HG_ATT(a_, b_, dst) do { dst = (f32x16){0.f,0.f,0.f,0.f,0.f,0.f,0.f,0.f,0.f,0.f,0.f,0.f,0.f,0.f,0.f,0.f}; \
            _Pragma("unroll") for (int k = 0; k < 8; ++k) { const bf16x8 ka_ = *(const LAS bf16x8*)(R + HG_KI + (32 * (a_) + c31) * HG_RP + (k * 16 + 8 * hi) * 2), qb_ = *(const LAS bf16x8*)(R + HG_QI + (32 * (b_) + c31) * HG_RP + (k * 16 + 8 * hi) * 2); \
                dst = __builtin_amdgcn_mfma_f32_32x32x16_bf16(ka_, qb_, dst, 0, 0, 0); } } while (0)
#define HG_PV(a_, t_, acc_) do { v4u p0_, p1_; p0_.x = cvtpk(t_[0], t_[1]); p0_.y = cvtpk(t_[2], t_[3]); p0_.z = cvtpk(t_[4], t_[5]); p0_.w = cvtpk(t_[6], t_[7]); \
            p1_.x = cvtpk(t_[8], t_[9]); p1_.y = cvtpk(t_[10], t_[11]); p1_.z = cvtpk(t_[12], t_[13]); p1_.w = cvtpk(t_[14], t_[15]); \
            LAS unsigned char* vb_ = R + HG_VV + (32 * (a_) + 4 * hi + trq) * HG_RP + 64 * j + trc; \
            const s16x4 a0_ = vtr(vb_), a1_ = vtr(vb_ + 8 * HG_RP), b0_ = vtr(vb_ + 16 * HG_RP), b1_ = vtr(vb_ + 24 * HG_RP); \
            acc_ = __builtin_amdgcn_mfma_f32_32x32x16_bf16((bf16x8){a0_[0], a0_[1], a0_[2], a0_[3], a1_[0], a1_[1], a1_[2], a1_[3]}, __builtin_bit_cast(bf16x8, p0_), acc_, 0, 0, 0); \
            acc_ = __builtin_amdgcn_mfma_f32_32x32x16_bf16((bf16x8){b0_[0], b0_[1], b0_[2], b0_[3], b1_[0], b1_[1], b1_[2], b1_[3]}, __builtin_bit_cast(bf16x8, p1_), acc_, 0, 0, 0); } while (0)
            f32x16 t;
            HG_ATT(0, 0, t);
#pragma unroll
            for (int r = 0; r < 16; ++r) t[r] = (CROW(r, hi) <= c31) ? t[r] : 0.f;
            HG_PV(0, t, ot0);
            HG_ATT(0, 1, t);
            HG_PV(0, t, ot1);
            HG_ATT(1, 1, t);
#pragma unroll
            for (int r = 0; r < 16; ++r) t[r] = (CROW(r, hi) <= c31) ? t[r] : 0.f;
            HG_PV(1, t, ot1);
#undef HG_ATT
#undef HG_PV
#pragma unroll
            for (int i = 0; i < 4; ++i) {
                const f32x4 e0 = *(const LAS f32x4*)(R + HG_EREF + (32 * i + 4 * hi) * 4), e1 = *(const LAS f32x4*)(R + HG_EREF + (32 * i + 4 * hi + 8) * 4),
                            e2 = *(const LAS f32x4*)(R + HG_EREF + (32 * i + 4 * hi + 16) * 4), e3 = *(const LAS f32x4*)(R + HG_EREF + (32 * i + 4 * hi + 24) * 4);
                v4u a0, a1;
                a0.x = cvtpk(S[i][0] * e0.x, S[i][1] * e0.y); a0.y = cvtpk(S[i][2] * e0.z, S[i][3] * e0.w); a0.z = cvtpk(S[i][4] * e1.x, S[i][5] * e1.y); a0.w = cvtpk(S[i][6] * e1.z, S[i][7] * e1.w);
                a1.x = cvtpk(S[i][8] * e2.x, S[i][9] * e2.y); a1.y = cvtpk(S[i][10] * e2.z, S[i][11] * e2.w); a1.z = cvtpk(S[i][12] * e3.x, S[i][13] * e3.y); a1.w = cvtpk(S[i][14] * e3.z, S[i][15] * e3.w);
#pragma unroll
                for (int ks = 0; ks < 2; ++ks) { const bf16x8 af = __builtin_bit_cast(bf16x8, ks ? a1 : a0);
#pragma unroll
                    for (int b = 0; b < 2; ++b) { LAS unsigned char* qb = R + HG_QI + (32 * b + c31) * HG_RP + (32 * i + 16 * ks + 4 * hi) * 2;
                        const s16x4 lo = *(const LAS s16x4*)qb, hh_ = *(const LAS s16x4*)(qb + 16);
                        const bf16x8 bfm = (bf16x8){lo[0], lo[1], lo[2], lo[3], hh_[0], hh_[1], hh_[2], hh_[3]};
                        if (b == 0) ot0 = __builtin_amdgcn_mfma_f32_32x32x16_bf16(af, bfm, ot0, 0, 0, 0); else ot1 = __builtin_amdgcn_mfma_f32_32x32x16_bf16(af, bfm, ot1, 0, 0, 0); } }
            }
#pragma unroll
            for (int b = 0; b < 2; ++b) { const int u = c * 64 + 32 * b + c31, tok = tokbase + (dir ? SEG - 1 - u : u);
                float* op = O + ((size_t)dir * MC + tok) * 512 + mhead * 128 + 32 * j + 4 * hi;
#pragma unroll
                for (int g = 0; g < 4; ++g) { f32x4 v; if (b == 0) v = (f32x4){ot0[4 * g], ot0[4 * g + 1], ot0[4 * g + 2], ot0[4 * g + 3]}; else v = (f32x4){ot1[4 * g], ot1[4 * g + 1], ot1[4 * g + 2], ot1[4 * g + 3]};
                    *(GAS f32x4*)(op + 8 * g) = v; } }
        }
#pragma unroll
        for (int i = 0; i < 4; ++i) {
            f32x16 U = {0.f,0.f,0.f,0.f,0.f,0.f,0.f,0.f,0.f,0.f,0.f,0.f,0.f,0.f,0.f,0.f};
#pragma unroll
            for (int k4 = 0; k4 < 4; ++k4) {
                LAS unsigned char* kb = R + HG_KI + (16 * k4 + 4 * hi + trq) * HG_RP + 64 * i + trc;
                LAS unsigned char* vb = R + HG_VV + (16 * k4 + 4 * hi + trq) * HG_RP + 64 * j + trc;
                const s16x4 ka = vtr(kb), kb2 = vtr(kb + 8 * HG_RP), va = vtr(vb), vb2 = vtr(vb + 8 * HG_RP);
                U = __builtin_amdgcn_mfma_f32_32x32x16_bf16((bf16x8){ka[0], ka[1], ka[2], ka[3], kb2[0], kb2[1], kb2[2], kb2[3]}, (bf16x8){va[0], va[1], va[2], va[3], vb2[0], vb2[1], vb2[2], vb2[3]}, U, 0, 0, 0);
            }
#pragma unroll
            for (int g = 0; g < 4; ++g) { const f32x4 dd = *(const LAS f32x4*)(R + HG_DD + (32 * i + 4 * hi + 8 * g) * 4), ee = *(const LAS f32x4*)(R + HG_EEND + (32 * i + 4 * hi + 8 * g) * 4);
                S[i][4 * g + 0] = dd.x * S[i][4 * g + 0] + ee.x * U[4 * g + 0]; S[i][4 * g + 1] = dd.y * S[i][4 * g + 1] + ee.y * U[4 * g + 1];
                S[i][4 * g + 2] = dd.z * S[i][4 * g + 2] + ee.z * U[4 * g + 2]; S[i][4 * g + 3] = dd.w * S[i][4 * g + 3] + ee.w * U[4 * g + 3]; }
        }
        __syncthreads();
    }
    if (!MODE) {
#pragma unroll
        for (int i = 0; i < 4; ++i)
#pragma unroll
            for (int r = 0; r < 16; ++r) SLOC[sidx + (i * 16 + r) * 64] = S[i][r];
        if (half == 0) DTOT[(size_t)((sg * 2 + dir) * 4 + headp) * 128 + ch] = dtot;
    }
}
__device__ __forceinline__ void hgrn_scan(const float* SLOC, float* SINIT, const float* DTOT, int T, int nseq, int gtid, int gstride) {
    const int nsegs = T / SEG;
    for (int it = gtid; it < nseq * 8 * 16384; it += gstride) { const int e = it & 16383, sdh = it >> 14, head = sdh & 3, dir = (sdh >> 2) & 1, seq = sdh >> 3;
        const int ln = e & 63, r = (e >> 6) & 15, i = (e >> 10) & 3, dk = 32 * i + CROW(r, ln >> 5);
        float run = 0.f;
        for (int k = 0; k < nsegs; ++k) { const int ss = dir ? nsegs - 1 - k : k; const size_t hid = (size_t)(((seq * nsegs + ss) * 2 + dir) * 4 + head);
            SINIT[hid * 16384 + e] = run; run = DTOT[hid * 128 + dk] * run + SLOC[hid * 16384 + e]; } }
}
constexpr int PARAM_OFF = LDSCTL_OFF + 512;
enum { P_XP = 0, P_XS, P_T5, P_WIE, P_SINK, P_WOE, P_WIO, P_RPB, P_LBD, P_GN, P_WOO, P_LNG, P_LNB, P_OUT, P_WS, NPARAM };
template <class Tp> __device__ __forceinline__ Tp* ldp(LAS unsigned char* lds, int i) {
    volatile LAS unsigned* PB = (volatile LAS unsigned*)(lds + PARAM_OFF);
    const unsigned lo = __builtin_amdgcn_readfirstlane(PB[2 * i]), hi = __builtin_amdgcn_readfirstlane(PB[2 * i + 1]);
    return (Tp*)(((unsigned long long)hi << 32) | lo);
}
struct Ctx { int tid, lane, wave, bid, G, gtid, gstride, gw, NGW; };
__device__ __forceinline__ Ctx mkctx() {
    Ctx c; int t = threadIdx.x; asm volatile("" : "+v"(t));
    c.tid = t; c.lane = t & 63; c.wave = __builtin_amdgcn_readfirstlane(t >> 6); c.bid = blockIdx.x; c.G = gridDim.x;
    c.gtid = c.bid * (NWAVES * 64) + t; c.gstride = c.G * NWAVES * 64; c.gw = c.bid * NWAVES + c.wave; c.NGW = c.G * NWAVES; return c;
}
struct Chunk { int row0, T, nseq; bool is_p; };
__device__ __forceinline__ Chunk mkchunk(int c) { Chunk k; k.row0 = c * MC; k.is_p = k.row0 < NP_TOK; k.T = k.is_p ? T_P : T_S; k.nseq = MC / k.T; return k; }
__device__ __forceinline__ const float* chunk_x(LAS unsigned char* lds, const Chunk& k) {
    return k.is_p ? ldp<const float>(lds, P_XP) + (size_t)k.row0 * DM : ldp<const float>(lds, P_XS) + (size_t)(k.row0 - NP_TOK) * DM; }
__device__ __forceinline__ void grid_bar(LAS unsigned char* lds) {
    XcdBarrier b; b.bar = (unsigned*)(ldp<unsigned char>(lds, P_WS) + WS_CTL) + CW_BAR; b.x = xb_xcc_id(); b.st = (volatile LAS unsigned*)(lds + MISC_OFF) + 8;
    xcd_barrier(b);
}

__device__ __forceinline__ void ph_weights(LAS unsigned char* lds) {
    const Ctx x = mkctx(); unsigned char* ws = ldp<unsigned char>(lds, P_WS);
    LAS float* scr = (LAS float*)(lds + x.wave * 16384);
    constexpr int I1 = (DM / 64) * (EVEN_IN / 32), I2 = (EVEN_OUT / 64) * (DM / 32), I3 = (DM / 64) * (ODD_IN / 32), I4 = (ODD_OUT / 64) * (DM / 32);
    for (int it = x.gw; it < I1 + I2 + I3 + I4; it += x.NGW) {
        int r = it;
        if (r < I1) { p0_transpose_item(ldp<const float>(lds, P_WIE), DM, EVEN_IN, (bf16*)(ws + WS_W1), scr, r, x.lane); continue; } r -= I1;
        if (r < I2) { p0_transpose_item(ldp<const float>(lds, P_WOE), EVEN_OUT, DM, (bf16*)(ws + WS_W2), scr, r, x.lane); continue; } r -= I2;
        if (r < I3) { p0_transpose_item(ldp<const float>(lds, P_WIO), DM, ODD_IN, (bf16*)(ws + WS_W3), scr, r, x.lane); continue; } r -= I3;
        p0_transpose_item(ldp<const float>(lds, P_WOO), ODD_OUT, DM, (bf16*)(ws + WS_W4), scr, r, x.lane);
    }
}
__device__ __forceinline__ void ph_convert(LAS unsigned char* lds, int c) {
    const Ctx x = mkctx(); const Chunk k = mkchunk(c); const float* xin = chunk_x(lds, k); bf16* XB = (bf16*)(ldp<unsigned char>(lds, P_WS) + WS_XB);
    for (int i = x.gtid; i < MC * DM / 8; i += x.gstride) { const f32x4 a = ((const GAS f32x4*)xin)[2 * i], b = ((const GAS f32x4*)xin)[2 * i + 1];
        v4u w; w.x = pk2(a.x, a.y); w.y = pk2(a.z, a.w); w.z = pk2(b.x, b.y); w.w = pk2(b.z, b.w); ((GAS v4u*)XB)[i] = w; }
}
template <int WOFF, int N> __device__ __forceinline__ void ph_gemm_in(LAS unsigned char* lds) {
    unsigned char* ws = ldp<unsigned char>(lds, P_WS);
    pg8::Gemm g{(const pg8::bf16_t*)(ws + WS_XB), (const pg8::bf16_t*)(ws + WOFF), MC, N, DM}; pg8::StaticOrder S; S.init(MC, N, (int)gridDim.x, (int)blockIdx.x);
    pg8::EpiBf16<0> E{(pg8::bf16_t*)(ws + WS_H), N, nullptr, 0, 0, 1.f};
    pg8::gemm_phase<pg8::EpiBf16<0>, pg8::StaticOrder, true, true>(lds, g, S, E);
}
template <int WOFF, int K> __device__ __forceinline__ void ph_gemm_out(LAS unsigned char* lds, const float* base) {
    unsigned char* ws = ldp<unsigned char>(lds, P_WS);
    pg8::Gemm g{(const pg8::bf16_t*)(ws + WS_Y), (const pg8::bf16_t*)(ws + WOFF), MC, DM, K}; pg8::StaticOrder S; S.init(MC, DM, (int)gridDim.x, (int)blockIdx.x);
    EpiResF32 E{base, (float*)(ws + WS_Z), DM, ALPHA};
    pg8::gemm_phase<EpiResF32, pg8::StaticOrder, true, true>(lds, g, S, E);
}
__device__ __forceinline__ void ph_ln(LAS unsigned char* lds, int c, int layer, bool to_bf16) {
    const Ctx x = mkctx(); const Chunk k = mkchunk(c); unsigned char* ws = ldp<unsigned char>(lds, P_WS);
    const float* Z = (const float*)(ws + WS_Z); float* outc = ldp<float>(lds, P_OUT) + (size_t)k.row0 * DM; bf16* XB = (bf16*)(ws + WS_XB);
    const float* g = ldp<const float>(lds, P_LNG) + layer * DM; const float* b = ldp<const float>(lds, P_LNB) + layer * DM;
    for (int m = x.gw; m < MC; m += x.NGW) ln_row(Z + (size_t)m * DM, g, b, outc + (size_t)m * DM, to_bf16 ? XB + (size_t)m * DM : nullptr, x.lane);
}
__device__ __forceinline__ void ph_even_mix(LAS unsigned char* lds, int c) {
    const Ctx x = mkctx(); const Chunk k = mkchunk(c); unsigned char* ws = ldp<unsigned char>(lds, P_WS);
#if NAIVE_EVEN
    naive_even((const bf16*)(ws + WS_H), (bf16*)(ws + WS_Y), k.T, ldp<const float>(lds, P_T5), ldp<const float>(lds, P_SINK), x.gtid, x.gstride);
#else
    const bf16* H = (const bf16*)(ws + WS_H); bf16* Y = (bf16*)(ws + WS_Y);
    even_tables(lds, ldp<const float>(lds, P_T5), x.tid);
    __syncthreads();
    LAS unsigned char* vl = lds + VT_OFF + x.wave * 4096;
    const float* sink = ldp<const float>(lds, P_SINK);
    for (int it = x.gw; it < (MC / 32) * 4; it += x.NGW) mixB_task(H, Y, k.T, lds, vl, it >> 2, it & 3, x.lane);
    for (int it = x.gw; it < (MC / 32) * 8; it += x.NGW) mixA_task(H, Y, k.T, sink, lds, vl, it >> 3, it & 7, x.lane);
    __syncthreads();
#endif
}
__device__ __forceinline__ void ph_odd_mix(LAS unsigned char* lds, int c) {
    const Ctx x = mkctx(); const Chunk k = mkchunk(c); unsigned char* ws = ldp<unsigned char>(lds, P_WS);
#if NAIVE_NA
    naive_na((const bf16*)(ws + WS_H), (bf16*)(ws + WS_Y), k.T, ldp<const float>(lds, P_RPB), x.gtid, x.gstride);
#else
    { const bf16* H = (const bf16*)(ws + WS_H); bf16* Y = (bf16*)(ws + WS_Y);
      odd_tables(lds, ldp<const float>(lds, P_RPB), x.tid);
      __syncthreads();
      LAS unsigned char* vl = lds + VT_OFF + x.wave * 4096;
      for (int it = x.gw; it < (MC / 32) * 8; it += x.NGW) mixC_task(H, Y, k.T, lds, vl, it >> 3, it & 7, x.lane);
      __syncthreads(); }
#endif
#if NAIVE_HGRN
    naive_hgrn((const bf16*)(ws + WS_H), (float*)(ws + WS_O), k.T, k.nseq, ldp<const float>(lds, P_LBD), lds, x.tid, x.bid, x.G);
#endif
}
#if !NAIVE_HGRN
template <int MODE> __device__ __forceinline__ void ph_hgrn(LAS unsigned char* lds, int c) {
    const Ctx x = mkctx(); const Chunk k = mkchunk(c); unsigned char* ws = ldp<unsigned char>(lds, P_WS);
    for (int task = x.bid; task < (MC / SEG) * 4; task += x.G)
        hgrn_seg_task<MODE>((const bf16*)(ws + WS_H), (float*)(ws + WS_O), (float*)(ws + WS_SLOC), (const float*)(ws + WS_SINIT), (float*)(ws + WS_DTOT), ldp<const float>(lds, P_LBD), k.T, lds, task, x.tid);
}
__device__ __forceinline__ void ph_hgrn_scan(LAS unsigned char* lds, int c) {
    const Ctx x = mkctx(); const Chunk k = mkchunk(c); unsigned char* ws = ldp<unsigned char>(lds, P_WS);
    hgrn_scan((const float*)(ws + WS_SLOC), (float*)(ws + WS_SINIT), (const float*)(ws + WS_DTOT), k.T, k.nseq, x.gtid, x.gstride);
}
#endif
__device__ __forceinline__ void ph_odd_combine(LAS unsigned char* lds) {
    const Ctx x = mkctx(); unsigned char* ws = ldp<unsigned char>(lds, P_WS);
    hgrn_combine((const bf16*)(ws + WS_H), (const float*)(ws + WS_O), (bf16*)(ws + WS_Y), ldp<const float>(lds, P_GN), x.gw, x.NGW, x.lane);
}

struct Args { const float* in[13]; float* out; unsigned char* ws; int pad0, pad1; };
__global__ void __launch_bounds__(NWAVES * 64, 2) mk_fwd(Args args) {
    extern __shared__ __attribute__((aligned(16))) unsigned char lds_raw[];
    LAS unsigned char* lds = (LAS unsigned char*)lds_raw;
    for (int u = threadIdx.x; u < (LDS_BYTES - LDSCTL_OFF) / 4; u += NWAVES * 64) ((LAS unsigned*)(lds + LDSCTL_OFF))[u] = 0u;
    __syncthreads();
    if (threadIdx.x == 0) { volatile LAS unsigned* PB = (volatile LAS unsigned*)(lds + PARAM_OFF);
#pragma unroll
        for (int i = 0; i < 13; ++i) { const unsigned long long p = (unsigned long long)args.in[i]; PB[2 * i] = (unsigned)p; PB[2 * i + 1] = (unsigned)(p >> 32); }
        { const unsigned long long p = (unsigned long long)args.out; PB[2 * P_OUT] = (unsigned)p; PB[2 * P_OUT + 1] = (unsigned)(p >> 32); }
        { const unsigned long long p = (unsigned long long)args.ws; PB[2 * P_WS] = (unsigned)p; PB[2 * P_WS + 1] = (unsigned)(p >> 32); } }
    __syncthreads();
    (void)xcd_barrier_post((unsigned*)(ldp<unsigned char>(lds, P_WS) + WS_CTL) + CW_BAR, (volatile LAS unsigned*)(lds + MISC_OFF) + 8);

    ph_weights(lds);
    for (int c = 0; c < NCH; ++c) {
        ph_convert(lds, c);                       grid_bar(lds);
        ph_gemm_in<(int)WS_W1, EVEN_IN>(lds);      grid_bar(lds);
        ph_even_mix(lds, c);                      grid_bar(lds);
        { const Chunk k = mkchunk(c); ph_gemm_out<(int)WS_W2, EVEN_OUT>(lds, chunk_x(lds, k)); }   grid_bar(lds);
        ph_ln(lds, c, 0, true);                   grid_bar(lds);
        ph_gemm_in<(int)WS_W3, ODD_IN>(lds);       grid_bar(lds);
#if NAIVE_HGRN
        ph_odd_mix(lds, c);                       grid_bar(lds);
#else
        ph_hgrn<0>(lds, c);                       grid_bar(lds);
        ph_odd_mix(lds, c); ph_hgrn_scan(lds, c); grid_bar(lds);
        ph_hgrn<1>(lds, c);                       grid_bar(lds);
#endif
        ph_odd_combine(lds);                      grid_bar(lds);
        { const Chunk k = mkchunk(c); ph_gemm_out<(int)WS_W4, ODD_OUT>(lds, ldp<const float>(lds, P_OUT) + (size_t)k.row0 * DM); }   grid_bar(lds);
        ph_ln(lds, c, 1, false);                  grid_bar(lds);
    }
}

extern "C" void kernel_launch(void* const* d_in, const int* in_sizes, int n_in, void* d_out, int out_size, void* d_ws, size_t ws_size, hipStream_t stream) {
    static int grid = 0;
    if (grid == 0) {
        if (n_in != 13 || out_size != NTOK * DM || ws_size < WS_END) { fprintf(stderr, "kernel_launch: unexpected shapes (n_in %d out %d ws %zu)\n", n_in, out_size, ws_size); grid = -1; return; }
        int dev = 0, cus = 0, per_cu = 0;
        (void)hipGetDevice(&dev); (void)hipDeviceGetAttribute(&cus, hipDeviceAttributeMultiprocessorCount, dev);
        (void)hipFuncSetAttribute((const void*)mk_fwd, hipFuncAttributeMaxDynamicSharedMemorySize, LDS_BYTES);
        (void)hipOccupancyMaxActiveBlocksPerMultiprocessor(&per_cu, (const void*)mk_fwd, NWAVES * 64, LDS_BYTES);
        (void)hipGetLastError();
        if (per_cu < 1) { fprintf(stderr, "kernel_launch: occupancy query says %d blocks per CU\n", per_cu); }
        grid = cus;
    }
    if (grid < 0) return;
    (void)hipMemsetAsync((char*)d_ws + WS_CTL, 0, CTL_ZERO_BYTES, stream);
    Args a{};
    for (int i = 0; i < 13; ++i) a.in[i] = (const float*)d_in[i];
    a.out = (float*)d_out; a.ws = (unsigned char*)d_ws;
    void* kargs[] = {&a};
    hipError_t e = hipLaunchCooperativeKernel((const void*)mk_fwd, dim3(grid), dim3(NWAVES * 64), kargs, LDS_BYTES, stream);
    if (e != hipSuccess) fprintf(stderr, "kernel_launch: cooperative launch failed: %s (grid %d)\n", hipGetErrorString(e), grid);
}
```

```cpp
#define NAIVE_EVEN 0
#define NAIVE_NA 0
#define NAIVE_HGRN 0
#define PROBE_DUP 0
#include <hip/hip_runtime.h>
#include <cstdio>
#include <cstdint>
namespace pg8 {
#define PG8_LAS __attribute__((address_space(3)))
typedef unsigned short bf16_t;
typedef short bf16x8 __attribute__((ext_vector_type(8)));
typedef float f32x4 __attribute__((ext_vector_type(4)));
typedef unsigned u32x4 __attribute__((ext_vector_type(4)));
constexpr int BM = 256, BK = 64, HALF = 128, HTB = HALF * BK * 2  , STAGE_BYTES = 8 * HTB, NXCD = 8, WGM = 8;

__host__ __device__ __forceinline__ int lds_byte(int r, int c) { const int st = (r >> 4) * 2 + (c >> 5), rr = r & 15, cc = c & 31, ob = rr * 64 + cc * 2; return st * 1024 + (ob ^ (((ob >> 9) & 1) << 5)); }
__host__ __device__ __forceinline__ void stage_rc(int b, int& R, int& C) { const int st = b / 1024, sb = b % 1024, swz = sb ^ (((sb >> 9) & 1) << 5); R = (st >> 1) * 16 + swz / 64; C = (st & 1) * 32 + (swz % 64) / 2; }
__host__ __device__ __forceinline__ int perm32(int rho) { const int n = rho >> 4, i = rho & 15; return 8 * (i >> 2) + 4 * n + (i & 3); }

struct Unit { int pm, pn; };
struct Gemm { const bf16_t* A; const bf16_t* Bt; int M, N, K; };

struct StaticOrder {
    int nM, nN, nwg, G, c;
    __host__ __device__ void init(int M, int N, int G_, int c_) { nM = M / BM; nN = N / BM; nwg = nM * nN; G = G_; c = c_; }
    __host__ __device__ bool next(int i, Unit& u) const {
        const long L = (long)i * G + c; if (L >= nwg) return false;
        int wgid = (int)L; { const int q = nwg / NXCD, r = nwg % NXCD, xcd = wgid % NXCD, off = wgid / NXCD; wgid = (xcd < r ? xcd * (q + 1) : r * (q + 1) + (xcd - r) * q) + off; }
        const int nig = WGM * nN, gid = wgid / nig, fm = gid * WGM, gsz = (nM - fm) < WGM ? (nM - fm) : WGM;
        u.pm = fm + ((wgid % nig) % gsz); u.pn = (wgid % nig) / gsz; return true;
    }
    __device__ __forceinline__ void a_ready(const Unit&) const {}
    __device__ __forceinline__ void done(const Unit&) const {}
};

__device__ __forceinline__ unsigned cvt_pk_bf16(float lo, float hi) { unsigned r; asm volatile("v_cvt_pk_bf16_f32 %0, %1, %2" : "=v"(r) : "v"(lo), "v"(hi)); return r; }
typedef float f32x2 __attribute__((ext_vector_type(2)));
__device__ __forceinline__ f32x2 gelu_pk(f32x2 v) {
    const f32x2 av = __builtin_elementwise_abs(v), d = av * 0.2316418882f + 1.0f;
    f32x2 t; t.x = __builtin_amdgcn_rcpf(d.x); t.y = __builtin_amdgcn_rcpf(d.y);
    f32x2 q = t * 0.5307027145f + (-0.7265760135f); q = q * t + 0.7107068705f; q = q * t + (-0.142248368f); q = q * t + 0.127414796f; q = q * t;
    const f32x2 s = (v * v) * (-0.72134752044f);
    f32x2 e; e.x = __builtin_amdgcn_exp2f(s.x); e.y = __builtin_amdgcn_exp2f(s.y);
    const f32x2 m = v * (q * e), r = v - m;
    f32x2 o; o.x = v.x < 0.f ? m.x : r.x; o.y = v.y < 0.f ? m.y : r.y; return o;
}

template <int ACT  > struct EpiBf16 {
    static constexpr bool PERM = true, AFTER_DRAIN = false; static_assert(ACT == 0 || ACT == 1, "EpiBf16: ACT is 0 (none) or 1 (gelu_pk)");
    bf16_t* O; int ldc; const float* bias; int split_cols; size_t split_stride; float scale0;
    __device__ __forceinline__ void operator()(const f32x4 (&acc)[2][2][4][2], const Unit& u, int wr, int wc, int fr, int fq) const {
        const int row0 = u.pm * BM + wr * 64 + fr; int colt = u.pn * BM; bf16_t* base = O;
        float sc = 1.f; if (split_cols) { const int t = colt / split_cols; base += (size_t)t * split_stride; colt -= t * split_cols; if (t == 0) sc = scale0; }
        const int col0 = colt + wc * 32 + 8 * fq, bcol0 = u.pn * BM + wc * 32 + 8 * fq;
        f32x4 bv[2][2];
#pragma unroll
        for (int bj = 0; bj < 2; ++bj)
#pragma unroll
            for (int n = 0; n < 2; ++n) bv[bj][n] = bias ? *(const f32x4*)(bias + bcol0 + bj * HALF + 4 * n) : (f32x4){0.f, 0.f, 0.f, 0.f};
#pragma unroll
        for (int ai = 0; ai < 2; ++ai)
#pragma unroll
            for (int m = 0; m < 4; ++m) { bf16_t* rowp = base + (size_t)(row0 + ai * HALF + m * 16) * ldc + col0;
#pragma unroll
                for (int bj = 0; bj < 2; ++bj) { f32x4 v0 = acc[ai][bj][m][0] + bv[bj][0], v1 = acc[ai][bj][m][1] + bv[bj][1];
                    if (ACT == 1) { f32x2 a = gelu_pk((f32x2){v0[0], v0[1]}), b = gelu_pk((f32x2){v0[2], v0[3]}), c = gelu_pk((f32x2){v1[0], v1[1]}), d = gelu_pk((f32x2){v1[2], v1[3]});
                        v0 = (f32x4){a.x, a.y, b.x, b.y}; v1 = (f32x4){c.x, c.y, d.x, d.y}; }
                    v0 = v0 * sc; v1 = v1 * sc; u32x4 w; w.x = cvt_pk_bf16(v0[0], v0[1]); w.y = cvt_pk_bf16(v0[2], v0[3]); w.z = cvt_pk_bf16(v1[0], v1[1]); w.w = cvt_pk_bf16(v1[2], v1[3]);
                    *(u32x4*)(rowp + bj * HALF) = w; } }
    }
};

struct PanelStats {
    unsigned* xbuf;
    unsigned* cnt;
    unsigned* tmo;
    int ntn; float eps;
    unsigned code;
    __device__ __forceinline__ bool run(const f32x4 (&v)[2][2][4][2], const Unit& u, int wr, int wc, int fr, int fq, PG8_LAS unsigned char* lds, int wid, int lane) const {
        typedef float f32x2v __attribute__((ext_vector_type(2)));
        PG8_LAS f32x2v* P = (PG8_LAS f32x2v*)lds;
        PG8_LAS f32x2v* S = (PG8_LAS f32x2v*)(lds + 8192);
        PG8_LAS unsigned* flag = (PG8_LAS unsigned*)(lds + 8192 + 2048);
#pragma unroll
        for (int ai = 0; ai < 2; ++ai)
#pragma unroll
            for (int m = 0; m < 4; ++m) {
                float s = 0.f;
#pragma unroll
                for (int bj = 0; bj < 2; ++bj)
#pragma unroll
                    for (int n = 0; n < 2; ++n) { const f32x4 x = v[ai][bj][m][n]; s += (x[0] + x[1]) + (x[2] + x[3]); }
                s += __shfl_xor(s, 16); s += __shfl_xor(s, 32);
                const float mw = s * (1.0f / 64.0f); float q = 0.f;
#pragma unroll
                for (int bj = 0; bj < 2; ++bj)
#pragma unroll
                    for (int n = 0; n < 2; ++n) { const f32x4 d = v[ai][bj][m][n] - mw; q += (d[0] * d[0] + d[1] * d[1]) + (d[2] * d[2] + d[3] * d[3]); }
                q += __shfl_xor(q, 16); q += __shfl_xor(q, 32);
                if (fq == 0) P[(ai * HALF + wr * 64 + m * 16 + fr) * 4 + wc] = (f32x2v){mw, q};
            }
        asm volatile("s_waitcnt lgkmcnt(0)" ::: "memory"); __builtin_amdgcn_s_barrier(); asm volatile("" ::: "memory");
#if defined(BROKEN_EXCHANGE_NO_WAIT)
#warning BROKEN CONTROL BUILD: the row-statistics exchange does not wait; results are wrong by design
        if (blockIdx.x >= 64) { const long long t0_ = clock64(); while (clock64() - t0_ < 60000) __builtin_amdgcn_s_sleep(8); }
#endif
        const int row = wid * 32 + (lane & 31);
        if (lane < 32) {
            const f32x2v a = P[row * 4 + 0], b = P[row * 4 + 1], c = P[row * 4 + 2], d = P[row * 4 + 3];
            const float mt = (a.x + b.x + c.x + d.x) * 0.25f;
            const float da = a.x - mt, db = b.x - mt, dc = c.x - mt, dd = d.x - mt;
            const float m2 = (a.y + b.y) + (c.y + d.y) + 64.0f * ((da * da + db * db) + (dc * dc + dd * dd));
            unsigned long long* slot = (unsigned long long*)xbuf + ((size_t)(u.pm * BM + row) * 4 + u.pn);
            __hip_atomic_store(slot, ((unsigned long long)__float_as_uint(m2) << 32) | __float_as_uint(mt), __ATOMIC_RELAXED, __HIP_MEMORY_SCOPE_AGENT);
        }
        asm volatile("s_waitcnt vmcnt(0)" ::: "memory");
        if (lane == 0) __hip_atomic_fetch_add(cnt + 64 * u.pm, 1u, __ATOMIC_RELAXED, __HIP_MEMORY_SCOPE_AGENT);
        if (wid == 0) {
            bool dead = false; const unsigned long long t0 = __builtin_amdgcn_s_memrealtime(); const unsigned want = 8u * (unsigned)ntn;
            for (;;) {
#if defined(BROKEN_EXCHANGE_NO_WAIT)
                break;
#endif
                if ((unsigned)__builtin_amdgcn_readfirstlane(__hip_atomic_load(cnt + 64 * u.pm, __ATOMIC_RELAXED, __HIP_MEMORY_SCOPE_AGENT)) >= want) break;
                if (__builtin_amdgcn_s_memrealtime() - t0 > 2000000ull) {
                    if (lane == 0) { unsigned expect = 0u; __hip_atomic_compare_exchange_strong(tmo + 1, &expect, code | (unsigned)(u.pm & 0xff), __ATOMIC_RELAXED, __ATOMIC_RELAXED, __HIP_MEMORY_SCOPE_AGENT);
                                     __hip_atomic_store(tmo, 1u, __ATOMIC_RELAXED, __HIP_MEMORY_SCOPE_AGENT); }
                    dead = true; break; }
                __builtin_amdgcn_s_sleep(2);
            }
            __builtin_amdgcn_fence(__ATOMIC_ACQUIRE, "agent");
            if (lane == 0) flag[0] = dead ? 1u : 0u;
        }
        asm volatile("s_waitcnt vmcnt(0) lgkmcnt(0)" ::: "memory"); __builtin_amdgcn_s_barrier(); asm volatile("" ::: "memory");
        const bool bad = flag[0] != 0u;
        if (lane < 32) {
            const unsigned long long* slot = (const unsigned long long*)xbuf + (size_t)(u.pm * BM + row) * 4; float mt[4], m2[4]; float ms = 0.f;
#pragma unroll
            for (int t = 0; t < 4; ++t) { if (t < ntn) { const unsigned long long w = __hip_atomic_load(slot + t, __ATOMIC_RELAXED, __HIP_MEMORY_SCOPE_AGENT); mt[t] = __uint_as_float((unsigned)w); m2[t] = __uint_as_float((unsigned)(w >> 32)); } else { mt[t] = 0.f; m2[t] = 0.f; } ms += mt[t]; }
            const float mean = ms / (float)ntn; float q = 0.f;
#pragma unroll
            for (int t = 0; t < 4; ++t) if (t < ntn) { const float dm = mt[t] - mean; q += m2[t] + 256.0f * dm * dm; }
            S[row] = (f32x2v){mean, 1.0f / sqrtf(q / (256.0f * (float)ntn) + eps)};
        }
        asm volatile("s_waitcnt lgkmcnt(0)" ::: "memory"); __builtin_amdgcn_s_barrier(); asm volatile("" ::: "memory");
        return bad;
    }
};
struct EpiLnRes {
    static constexpr bool PERM = false, AFTER_DRAIN = true;
    const float* base; float* out; int ldc; const float* bias; PanelStats st; unsigned poison;
    __device__ __forceinline__ void fused(f32x4 (&acc)[2][2][4][2], const Unit& u, int wr, int wc, int fr, int fq, PG8_LAS unsigned char* lds, int wid, int lane) const {
        typedef float f32x2v __attribute__((ext_vector_type(2)));
        const PG8_LAS f32x2v* S = (const PG8_LAS f32x2v*)(lds + 8192);
        const int col0 = u.pn * BM + wc * 32 + 4 * fq;
#pragma unroll
        for (int bj = 0; bj < 2; ++bj)
#pragma unroll
            for (int n = 0; n < 2; ++n) { const f32x4 bv = bias ? *(const f32x4*)(bias + col0 + bj * HALF + n * 16) : (f32x4){0.f, 0.f, 0.f, 0.f};
#pragma unroll
                for (int ai = 0; ai < 2; ++ai)
#pragma unroll
                    for (int m = 0; m < 4; ++m) acc[ai][bj][m][n] += bv; }
        f32x4 pre[4][2][2];
#pragma unroll
        for (int m = 0; m < 4; ++m) { const size_t off = (size_t)(u.pm * BM + wr * 64 + m * 16 + fr) * ldc + col0;
#pragma unroll
            for (int bj = 0; bj < 2; ++bj)
#pragma unroll
                for (int n = 0; n < 2; ++n) pre[m][bj][n] = *(const f32x4*)(base + off + bj * HALF + n * 16); }
        const bool bad = st.run(acc, u, wr, wc, fr, fq, lds, wid, lane) || poison != 0u;
        const float qnan = __builtin_nanf("");
#pragma unroll
        for (int ai = 0; ai < 2; ++ai)
#pragma unroll
            for (int m = 0; m < 4; ++m) { const int r = ai * HALF + wr * 64 + m * 16 + fr; const f32x2v sr = S[r]; const size_t off = (size_t)(u.pm * BM + r) * ldc + col0;
#pragma unroll
                for (int bj = 0; bj < 2; ++bj)
#pragma unroll
                    for (int n = 0; n < 2; ++n) { const f32x4 bs = ai == 0 ? pre[m][bj][n] : *(const f32x4*)(base + off + bj * HALF + n * 16); f32x4 o = bs + (acc[ai][bj][m][n] - sr.x) * sr.y;
                        if (bad) o = (f32x4){qnan, qnan, qnan, qnan}; *(f32x4*)(out + off + bj * HALF + n * 16) = o; }
                if (m & 1) asm volatile("" ::: "memory"); }
    }
};
struct EpiLnResLn {
    static constexpr bool PERM = false, AFTER_DRAIN = true;
    const float* base; float* out; bf16_t* xn; int ldc; const float* bias; PanelStats st1, st2; unsigned poison;
    __device__ __forceinline__ void fused(f32x4 (&acc)[2][2][4][2], const Unit& u, int wr, int wc, int fr, int fq, PG8_LAS unsigned char* lds, int wid, int lane) const {
        typedef float f32x2v __attribute__((ext_vector_type(2))); typedef unsigned u32x2v __attribute__((ext_vector_type(2)));
        const PG8_LAS f32x2v* S = (const PG8_LAS f32x2v*)(lds + 8192);
        const int col0 = u.pn * BM + wc * 32 + 4 * fq;
#pragma unroll
        for (int bj = 0; bj < 2; ++bj)
#pragma unroll
            for (int n = 0; n < 2; ++n) { const f32x4 bv = bias ? *(const f32x4*)(bias + col0 + bj * HALF + n * 16) : (f32x4){0.f, 0.f, 0.f, 0.f};
#pragma unroll
                for (int ai = 0; ai < 2; ++ai)
#pragma unroll
                    for (int m = 0; m < 4; ++m) acc[ai][bj][m][n] += bv; }
        bool bad = st1.run(acc, u, wr, wc, fr, fq, lds, wid, lane) || poison != 0u;
        const float qnan = __builtin_nanf("");
#pragma unroll
        for (int ai = 0; ai < 2; ++ai)
#pragma unroll
            for (int m = 0; m < 4; ++m) { const int r = ai * HALF + wr * 64 + m * 16 + fr; const f32x2v sr = S[r]; const size_t off = (size_t)(u.pm * BM + r) * ldc + col0;
#pragma unroll
                for (int bj = 0; bj < 2; ++bj)
#pragma unroll
                    for (int n = 0; n < 2; ++n) { const f32x4 bs = *(const f32x4*)(base + off + bj * HALF + n * 16); acc[ai][bj][m][n] = bs + (acc[ai][bj][m][n] - sr.x) * sr.y; }
                asm volatile("" : "+v"(acc[ai][0][m][0]), "+v"(acc[ai][0][m][1]), "+v"(acc[ai][1][m][0]), "+v"(acc[ai][1][m][1]));
                if (m & 1) asm volatile("" ::: "memory"); }
        const bool bad1 = bad;
        bad = st2.run(acc, u, wr, wc, fr, fq, lds, wid, lane) || bad;
#pragma unroll
        for (int ai = 0; ai < 2; ++ai)
#pragma unroll
            for (int m = 0; m < 4; ++m) { const int r = ai * HALF + wr * 64 + m * 16 + fr; const f32x2v sr = S[r]; const size_t off = (size_t)(u.pm * BM + r) * ldc + col0;
#pragma unroll
                for (int bj = 0; bj < 2; ++bj)
#pragma unroll
                    for (int n = 0; n < 2; ++n) { const f32x4 x1 = acc[ai][bj][m][n]; *(f32x4*)(out + off + bj * HALF + n * 16) = bad1 ? (f32x4){qnan, qnan, qnan, qnan} : x1;
                        const f32x4 o = (x1 - sr.x) * sr.y; u32x2v w; w.x = cvt_pk_bf16(o[0], o[1]); w.y = cvt_pk_bf16(o[2], o[3]);
                        if (bad) { w.x = 0x7fc07fc0u; w.y = 0x7fc07fc0u; } *(u32x2v*)(xn + off + bj * HALF + n * 16) = w; }
                asm volatile("" ::: "memory"); }
    }
};

template <class Epi, class Sched, bool ALIGN_EPI = false, bool SP2 = false>
__device__ __forceinline__ void gemm_phase(PG8_LAS unsigned char* lds, const Gemm g, const Sched& S, const Epi& E) {
    int tid_ = threadIdx.x; asm volatile("" : "+v"(tid_));
    const int tid = tid_, wid = __builtin_amdgcn_readfirstlane(tid >> 6), lane = tid & 63, wr = wid >> 2, wc = wid & 3, fr = lane & 15, fq = lane >> 4;
    const int K = g.K, nt = K / BK;
    unsigned voffA[2], voffB[2];
#pragma unroll
    for (int i = 0; i < 2; ++i) { int R, C; stage_rc(tid * 16 + i * 8192, R, C); const int Rb = Epi::PERM ? ((R & ~31) + perm32(R & 31)) : R;
        voffA[i] = (unsigned)(R * K + C) * 2u; voffB[i] = (unsigned)(Rb * K + C) * 2u; }
    const size_t kstep = (size_t)(BK * 2);
    const size_t hstep = (size_t)HALF * K * 2;
    const size_t tstep = 2 * hstep;
    const unsigned ldsw = (unsigned)wid * 1024u;
    const int aoff = lds_byte(wr * 64 + fr, fq * 8), boff = lds_byte(wc * 32 + fr, fq * 8);
#define PG8_SA(b, h) (((b) * 2 + (h)) * HTB)
#define PG8_SB(b, h) ((4 + (b) * 2 + (h)) * HTB)
#define PG8_STAGE(bufoff, gbase, voff) do { _Pragma("unroll") for (int _i = 0; _i < 2; ++_i) \
        __builtin_amdgcn_global_load_lds((const unsigned*)((const char*)(gbase) + (voff)[_i]), (PG8_LAS unsigned*)(lds + (bufoff) + ldsw + _i * 8192), 16, 0, 0); } while (0)
#define PG8_LDA(dst, b, h) do { _Pragma("unroll") for (int m = 0; m < 4; ++m) _Pragma("unroll") for (int k = 0; k < 2; ++k) dst[m][k] = *(const PG8_LAS bf16x8*)(lds + PG8_SA(b, h) + aoff + m * 2048 + k * 1024); } while (0)
#define PG8_LDB(dst, b, h) do { _Pragma("unroll") for (int n = 0; n < 2; ++n) _Pragma("unroll") for (int k = 0; k < 2; ++k) dst[n][k] = *(const PG8_LAS bf16x8*)(lds + PG8_SB(b, h) + boff + n * 2048 + k * 1024); } while (0)
#define PG8_MMA(ai, bj, At, Bt) do { __builtin_amdgcn_s_setprio(1); _Pragma("unroll") for (int m = 0; m < 4; ++m) _Pragma("unroll") for (int n = 0; n < 2; ++n) _Pragma("unroll") for (int k = 0; k < 2; ++k) \
        acc[ai][bj][m][n] = __builtin_amdgcn_mfma_f32_16x16x32_bf16(Bt[n][k], At[m][k], acc[ai][bj][m][n], 0, 0, 0); __builtin_amdgcn_s_setprio(0); } while (0)
#define PG8_WAIT_V(n) asm volatile("s_waitcnt vmcnt(" #n ")" ::: "memory")
#define PG8_WAIT_L(n) asm volatile("s_waitcnt lgkmcnt(" #n ")" ::: "memory")
#define PG8_BAR __builtin_amdgcn_s_barrier()
#define PG8_SCHED __builtin_amdgcn_sched_barrier(0)
    Unit cur, nxt; int ui = 0;
    if (!S.next(0, cur)) return;
    f32x4 acc[2][2][4][2];
#pragma unroll
    for (int a = 0; a < 2; ++a)
#pragma unroll
        for (int b = 0; b < 2; ++b)
#pragma unroll
            for (int m = 0; m < 4; ++m)
#pragma unroll
                for (int n = 0; n < 2; ++n) acc[a][b][m][n] = (f32x4){0.f, 0.f, 0.f, 0.f};
    bf16x8 At[4][2], B0[2][2], B1[2][2];
    const char* cA = (const char*)g.A + (size_t)cur.pm * tstep; const char* cB = (const char*)g.Bt + (size_t)cur.pn * tstep;
    S.a_ready(cur);
    if constexpr (SP2) {
        PG8_STAGE(PG8_SB(0, 0), cB, voffB); PG8_STAGE(PG8_SB(0, 1), cB + hstep, voffB); PG8_STAGE(PG8_SA(0, 0), cA, voffA); PG8_STAGE(PG8_SA(0, 1), cA + hstep, voffA);
        if (wr == 1) PG8_BAR;
        PG8_WAIT_V(2); PG8_BAR;
        PG8_STAGE(PG8_SB(1, 0), cB + kstep, voffB); PG8_STAGE(PG8_SA(1, 0), cA + kstep, voffA); PG8_STAGE(PG8_SB(1, 1), cB + hstep + kstep, voffB);
        PG8_WAIT_V(6); PG8_BAR;
    } else {
        PG8_STAGE(PG8_SB(0, 0), cB, voffB); PG8_STAGE(PG8_SA(0, 0), cA, voffA); PG8_STAGE(PG8_SB(0, 1), cB + hstep, voffB); PG8_STAGE(PG8_SA(0, 1), cA + hstep, voffA);
        if (wr == 1) PG8_BAR;
        PG8_WAIT_V(4); PG8_BAR;
        PG8_STAGE(PG8_SB(1, 0), cB + kstep, voffB); PG8_STAGE(PG8_SA(1, 0), cA + kstep, voffA); PG8_STAGE(PG8_SB(1, 1), cB + hstep + kstep, voffB);
        PG8_WAIT_V(6); PG8_BAR;
    }
    for (;;) {
        const bool has_next = S.next(ui + 1, nxt);
        const char* nA = has_next ? (const char*)g.A + (size_t)nxt.pm * tstep : cA; const char* nB = has_next ? (const char*)g.Bt + (size_t)nxt.pn * tstep : cB;
        for (int t = 0; t < nt; t += 2) {
            const bool last = (t == nt - 2);
            const char* a1 = cA + (size_t)(t + 1) * kstep;
            const char* a2 = last ? nA : cA + (size_t)(t + 2) * kstep; const char* b2 = last ? nB : cB + (size_t)(t + 2) * kstep;
            const char* a3 = a2 + kstep; const char* b3 = b2 + kstep;
            if (last && has_next) S.a_ready(nxt);
            if constexpr (SP2) {
            PG8_LDB(B0, 0, 0); PG8_LDB(B1, 0, 1); PG8_SCHED; PG8_LDA(At, 0, 0); PG8_STAGE(PG8_SA(1, 1), a1 + hstep, voffA);
            PG8_WAIT_V(8); PG8_WAIT_L(0); PG8_BAR; PG8_MMA(0, 0, At, B0); PG8_MMA(0, 1, At, B1); PG8_BAR; PG8_SCHED;
            PG8_LDA(At, 0, 1); PG8_STAGE(PG8_SB(0, 0), b2, voffB); PG8_STAGE(PG8_SB(0, 1), b2 + hstep, voffB); PG8_STAGE(PG8_SA(0, 0), a2, voffA);
            PG8_WAIT_V(8); PG8_WAIT_L(0); PG8_BAR; PG8_MMA(1, 0, At, B0); PG8_MMA(1, 1, At, B1); PG8_BAR; PG8_SCHED;
            PG8_LDB(B0, 1, 0); PG8_LDB(B1, 1, 1); PG8_SCHED; PG8_LDA(At, 1, 0); PG8_STAGE(PG8_SA(0, 1), a2 + hstep, voffA);
            PG8_WAIT_V(8); PG8_WAIT_L(0); PG8_BAR; PG8_MMA(0, 0, At, B0); PG8_MMA(0, 1, At, B1); PG8_BAR; PG8_SCHED;
            PG8_LDA(At, 1, 1); PG8_STAGE(PG8_SB(1, 0), b3, voffB); PG8_STAGE(PG8_SB(1, 1), b3 + hstep, voffB); PG8_STAGE(PG8_SA(1, 0), a3, voffA);
            PG8_WAIT_V(8); PG8_WAIT_L(0); PG8_BAR; PG8_MMA(1, 0, At, B0); PG8_MMA(1, 1, At, B1); PG8_BAR; PG8_SCHED;
            } else {
            PG8_LDB(B0, 0, 0); PG8_SCHED; PG8_LDA(At, 0, 0); PG8_STAGE(PG8_SA(1, 1), a1 + hstep, voffA);
            PG8_WAIT_L(8); PG8_BAR; PG8_WAIT_L(0); PG8_MMA(0, 0, At, B0); PG8_BAR; PG8_SCHED;
            PG8_LDB(B1, 0, 1); PG8_STAGE(PG8_SB(0, 0), b2, voffB);
            PG8_BAR; PG8_WAIT_L(0); PG8_MMA(0, 1, At, B1); PG8_BAR;
            PG8_LDA(At, 0, 1); PG8_STAGE(PG8_SA(0, 0), a2, voffA);
            PG8_BAR; PG8_WAIT_L(0); PG8_MMA(1, 0, At, B0); PG8_BAR; PG8_SCHED;
            PG8_STAGE(PG8_SB(0, 1), b2 + hstep, voffB);
            PG8_WAIT_V(6); PG8_BAR; PG8_MMA(1, 1, At, B1); PG8_BAR;
            PG8_LDB(B0, 1, 0); PG8_SCHED; PG8_LDA(At, 1, 0); PG8_STAGE(PG8_SA(0, 1), a2 + hstep, voffA);
            PG8_WAIT_L(8); PG8_BAR; PG8_WAIT_L(0); PG8_MMA(0, 0, At, B0); PG8_BAR; PG8_SCHED;
            PG8_LDB(B1, 1, 1); PG8_STAGE(PG8_SB(1, 0), b3, voffB);
            PG8_BAR; PG8_WAIT_L(0); PG8_MMA(0, 1, At, B1); PG8_BAR;
            PG8_LDA(At, 1, 1); PG8_STAGE(PG8_SA(1, 0), a3, voffA);
            PG8_BAR; PG8_WAIT_L(0); PG8_MMA(1, 0, At, B0); PG8_BAR; PG8_SCHED;
            PG8_STAGE(PG8_SB(1, 1), b3 + hstep, voffB);
            PG8_WAIT_V(6); PG8_BAR; PG8_MMA(1, 1, At, B1); PG8_BAR;
            }
        }
        if constexpr (ALIGN_EPI) { if (wr == 0) PG8_BAR; }
        if constexpr (!Epi::AFTER_DRAIN) { E(acc, cur, wr, wc, fr, fq); S.done(cur); }
        if (!has_next) break;
#pragma unroll
        for (int a = 0; a < 2; ++a)
#pragma unroll
            for (int b = 0; b < 2; ++b)
#pragma unroll
                for (int m = 0; m < 4; ++m)
#pragma unroll
                    for (int n = 0; n < 2; ++n) acc[a][b][m][n] = (f32x4){0.f, 0.f, 0.f, 0.f};
        cur = nxt; cA = nA; cB = nB; ++ui;
        if constexpr (ALIGN_EPI) { if (wr == 1) PG8_BAR; }
    }
    PG8_WAIT_V(0);
    if constexpr (!ALIGN_EPI) { if (wr == 0) PG8_BAR; }
    PG8_BAR;
    if constexpr (Epi::AFTER_DRAIN) { E.fused(acc, cur, wr, wc, fr, fq, lds, wid, lane); S.done(cur); }
#undef PG8_SA
#undef PG8_SB
#undef PG8_STAGE
#undef PG8_LDA
#undef PG8_LDB
#undef PG8_MMA
#undef PG8_WAIT_V
#undef PG8_WAIT_L
#undef PG8_BAR
#undef PG8_SCHED
}
}
#define GAS __attribute__((address_space(1)))
#define LAS __attribute__((address_space(3)))
typedef unsigned short bf16;
typedef unsigned v4u __attribute__((ext_vector_type(4)));
typedef float f32x4 __attribute__((ext_vector_type(4)));
typedef short bf16x8 __attribute__((ext_vector_type(8)));
typedef GAS unsigned gu32;
typedef GAS unsigned long long gu64;
#define RLX_AGENT __ATOMIC_RELAXED, __HIP_MEMORY_SCOPE_AGENT
#define LDS_WAIT() asm volatile("s_waitcnt lgkmcnt(0)" ::: "memory")
#define VM_WAIT() asm volatile("s_waitcnt vmcnt(0)" ::: "memory")
__device__ __forceinline__ unsigned long long rt() { return __builtin_amdgcn_s_memrealtime(); }
__device__ __forceinline__ unsigned f2bf(float f) { unsigned u = __builtin_bit_cast(unsigned, f); return (u + 0x7fffu + ((u >> 16) & 1u)) >> 16; }
__device__ __forceinline__ unsigned pk2(float lo, float hi) { return f2bf(lo) | (f2bf(hi) << 16); }

#define XB_TMO      128
#define XB_XCNT(j)  (256  + 64 * (j))
#define XB_XSUB(j)  (1280 + 64 * (j))
#define XB_XGEN(j)  (2304 + 64 * (j))
#define XB_TOP      3328
#define XB_TOPGEN   3392
#define XCD_BAR_WORDS 3456
#define XB_SPIN_CAP (1u << 18)

__device__ __forceinline__ unsigned xb_ld(unsigned* p)              { return __hip_atomic_load(p, __ATOMIC_RELAXED, __HIP_MEMORY_SCOPE_AGENT); }
__device__ __forceinline__ unsigned xb_add(unsigned* p, unsigned v) { return __hip_atomic_fetch_add(p, v, __ATOMIC_RELAXED, __HIP_MEMORY_SCOPE_AGENT); }
__device__ __forceinline__ unsigned xb_xcc_id() { return (unsigned)__builtin_amdgcn_s_getreg((3 << 11) | 20) & 0xFu; }
#define XB_SPIN(cond, bar) do { unsigned _sp = 0; while (cond) { __builtin_amdgcn_s_sleep(1); \
    if ((++_sp & 255u) == 0u) { if (xb_ld(&(bar)[XB_TMO])) break; if (_sp > XB_SPIN_CAP) { atomicAdd(&(bar)[XB_TMO], 1u); break; } } } } while (0)

struct XcdBarrier {
    unsigned* bar; unsigned x;
    volatile LAS unsigned* st;
};

__device__ __forceinline__ XcdBarrier xcd_barrier_post(unsigned* bar, volatile LAS unsigned* st) {
    XcdBarrier b; b.bar = bar; b.x = xb_xcc_id(); b.st = st;
    if (threadIdx.x == 0) (void)xb_add(&bar[XB_XCNT(b.x)], 1u);
    return b;
}
__device__ __forceinline__ void xcd_barrier_complete(unsigned* bar, unsigned x, unsigned& nloc, unsigned& nx) {
    const unsigned G = gridDim.x * gridDim.y * gridDim.z;
    unsigned sum, cnt, mine, sp = 0u;
    for (;;) {
        sum = 0u; cnt = 0u; mine = 0u;
#pragma unroll
        for (unsigned j = 0; j < 16; ++j) { const unsigned c = xb_ld(&bar[XB_XCNT(j)]); sum += c; cnt += (c > 0u) ? 1u : 0u; mine = (j == x) ? c : mine; }
        if (sum == G) break;
        __builtin_amdgcn_s_sleep(1);
        if ((++sp & 255u) == 0u) { if (xb_ld(&bar[XB_TMO])) break; if (sp > XB_SPIN_CAP) { atomicAdd(&bar[XB_TMO], 1u); break; } }
    }
    nloc = mine > 0u ? mine : 1u; nx = cnt > 0u ? cnt : 1u;
}

__device__ __forceinline__ void xcd_barrier(const XcdBarrier& b) {
    asm volatile("s_waitcnt vmcnt(0)" ::: "memory");
    __syncthreads();
    if (threadIdx.x == 0) {
        unsigned* bar = b.bar;
        __builtin_amdgcn_s_waitcnt(0);
        unsigned nloc = b.st[0], nx = b.st[1];
        if (nloc == 0u) { xcd_barrier_complete(bar, b.x, nloc, nx); b.st[0] = nloc; b.st[1] = nx; }
        const unsigned old = xb_add(&bar[XB_XSUB(b.x)], 1u);
        const unsigned gen = old / nloc;
        if (old + 1u == (gen + 1u) * nloc) {
            __builtin_amdgcn_fence(__ATOMIC_RELEASE, "agent");
            asm volatile("s_waitcnt vmcnt(0)" ::: "memory");
            const unsigned og = xb_add(&bar[XB_TOP], 1u);
            const unsigned tg = og / nx;
            if (og + 1u == (tg + 1u) * nx) xb_add(&bar[XB_TOPGEN], 1u);
            else XB_SPIN(xb_ld(&bar[XB_TOPGEN]) == tg, bar);
            __builtin_amdgcn_fence(__ATOMIC_ACQUIRE, "agent");
            xb_add(&bar[XB_XGEN(b.x)], 1u);
            asm volatile("s_waitcnt vmcnt(0)" ::: "memory");
        } else {
            XB_SPIN(xb_ld(&bar[XB_XGEN(b.x)]) == gen, bar);
            __builtin_amdgcn_fence(__ATOMIC_ACQUIRE, "agent");
            asm volatile("s_waitcnt vmcnt(0)" ::: "memory");
        }
    }
    __syncthreads();
}

constexpr int NWAVES = 8;
constexpr int DM = 1024;
constexpr int NP_TOK = 16 * 4096, NS_TOK = 2 * 16384, NTOK = NP_TOK + NS_TOK;
constexpr int T_P = 4096, T_S = 16384;
constexpr int MC = 32768, NCH = NTOK / MC;
constexpr int EVEN_IN = 3840, EVEN_OUT = 768, ODD_IN = 4608, ODD_OUT = 1024;
constexpr float ALPHA = 1.4142135623730951f;
constexpr float LN_EPS = 1e-5f, RMS_EPS = 1e-6f;

constexpr size_t MiB = 1u << 20;
constexpr size_t WS_CTL = 0, CTL_ZERO_BYTES = 1 * MiB;
constexpr size_t WS_W1 = 2 * MiB;
constexpr size_t WS_W2 = 10 * MiB;
constexpr size_t WS_W3 = 12 * MiB;
constexpr size_t WS_W4 = 22 * MiB;
constexpr size_t WS_XB = 32 * MiB;
constexpr size_t WS_H  = 96 * MiB;
constexpr size_t WS_Y  = 384 * MiB;
constexpr size_t WS_Z  = 448 * MiB;
constexpr size_t WS_O  = 576 * MiB;
constexpr size_t WS_SLOC = 704 * MiB;
constexpr size_t WS_SINIT = 736 * MiB;
constexpr size_t WS_DTOT = 768 * MiB;
constexpr size_t WS_END = 770 * MiB;
constexpr int CW_BAR = 4096;

constexpr int RING_BYTES = 131072;
constexpr int LDSCTL_OFF = RING_BYTES, MISC_OFF = LDSCTL_OFF + 320;
constexpr int LDS_BYTES = 147456;

__device__ __forceinline__ float bf2f(unsigned short b) { return __builtin_bit_cast(float, (unsigned)b << 16); }
__device__ __forceinline__ float bflo(unsigned u) { return __builtin_bit_cast(float, u << 16); }
__device__ __forceinline__ float bfhi(unsigned u) { return __builtin_bit_cast(float, u & 0xffff0000u); }
__device__ __forceinline__ float sigmoidf_(float x) { return 1.f / (1.f + __expf(-x)); }
__device__ __forceinline__ float siluf_(float x) { return x / (1.f + __expf(-x)); }

__device__ __forceinline__ int t5_bucket(int rel) {
    const int n = rel < 0 ? -rel : rel;
    int b = n < 8 ? n : n < 15 ? 8 : n < 27 ? 9 : n < 50 ? 10 : n < 91 ? 11 : n < 166 ? 12 : n < 305 ? 13 : n < 559 ? 14 : 15;
    return b + (rel > 0 ? 16 : 0);
}

__device__ __forceinline__ float wave_sum(float v) {
#pragma unroll
    for (int o = 1; o < 64; o <<= 1) v += __shfl_xor(v, o);
    return v;
}

__device__ __forceinline__ void p0_transpose_item(const float* W, int K, int N, bf16* WT, LAS float* scr, int item, int lane) {
    const int nblk = N / 32, kb = item / nblk, nb = item % nblk, k0 = 64 * kb, n0 = 32 * nb;
#pragma unroll 8
    for (int i = 0; i < 32; ++i) { const int kk = 2 * i + (lane >> 5); scr[kk * 33 + (lane & 31)] = W[(size_t)(k0 + kk) * N + n0 + (lane & 31)]; }
    LDS_WAIT(); asm volatile("" ::: "memory");
    const int c = lane & 7;
#pragma unroll
    for (int j = 0; j < 4; ++j) { const int n = (lane >> 3) + 8 * j; const LAS float* s = scr + (8 * c) * 33 + n;
        v4u o; o.x = pk2(s[0 * 33], s[1 * 33]); o.y = pk2(s[2 * 33], s[3 * 33]); o.z = pk2(s[4 * 33], s[5 * 33]); o.w = pk2(s[6 * 33], s[7 * 33]);
        *(GAS v4u*)(WT + (size_t)(n0 + n) * K + k0 + 8 * c) = o; }
    LDS_WAIT(); asm volatile("" ::: "memory");
}

struct EpiResF32 {
    static constexpr bool PERM = false, AFTER_DRAIN = false;
    const float* base; float* out; int ldc; float alpha;
    __device__ __forceinline__ void operator()(const pg8::f32x4 (&acc)[2][2][4][2], const pg8::Unit& u, int wr, int wc, int fr, int fq) const {
        const int col0 = u.pn * pg8::BM + wc * 32 + 4 * fq;
#pragma unroll
        for (int ai = 0; ai < 2; ++ai)
#pragma unroll
            for (int m = 0; m < 4; ++m) { const size_t off = (size_t)(u.pm * pg8::BM + ai * pg8::HALF + wr * 64 + m * 16 + fr) * ldc + col0;
#pragma unroll
                for (int bj = 0; bj < 2; ++bj)
#pragma unroll
                    for (int n = 0; n < 2; ++n) { const pg8::f32x4 bs = *(const pg8::f32x4*)(base + off + bj * pg8::HALF + n * 16);
                        *(pg8::f32x4*)(out + off + bj * pg8::HALF + n * 16) = bs * alpha + acc[ai][bj][m][n]; }
                asm volatile("" ::: "memory"); }
    }
};

__device__ __forceinline__ void load_row64(const bf16* p, float (&x)[64], float scale) {
#pragma unroll
    for (int c = 0; c < 8; ++c) { const v4u w = *(const GAS v4u*)(p + c * 8);
        x[c * 8 + 0] = bflo(w.x) * scale; x[c * 8 + 1] = bfhi(w.x) * scale; x[c * 8 + 2] = bflo(w.y) * scale; x[c * 8 + 3] = bfhi(w.y) * scale;
        x[c * 8 + 4] = bflo(w.z) * scale; x[c * 8 + 5] = bfhi(w.z) * scale; x[c * 8 + 6] = bflo(w.w) * scale; x[c * 8 + 7] = bfhi(w.w) * scale; }
}
__device__ __forceinline__ void attend(const bf16* krow, const bf16* vrow, const float (&q)[64], float bias, float& m, float& l, float (&o)[64]) {
    float dot = 0.f;
#pragma unroll
    for (int c = 0; c < 8; ++c) { const v4u w = *(const GAS v4u*)(krow + c * 8);
        dot += q[c * 8 + 0] * bflo(w.x) + q[c * 8 + 1] * bfhi(w.x) + q[c * 8 + 2] * bflo(w.y) + q[c * 8 + 3] * bfhi(w.y)
             + q[c * 8 + 4] * bflo(w.z) + q[c * 8 + 5] * bfhi(w.z) + q[c * 8 + 6] * bflo(w.w) + q[c * 8 + 7] * bfhi(w.w); }
    const float s = dot + bias, mn = fmaxf(m, s), a = __expf(m - mn), p = __expf(s - mn);
    l = l * a + p; m = mn;
#pragma unroll
    for (int c = 0; c < 8; ++c) { const v4u w = *(const GAS v4u*)(vrow + c * 8);
        o[c * 8 + 0] = o[c * 8 + 0] * a + p * bflo(w.x); o[c * 8 + 1] = o[c * 8 + 1] * a + p * bfhi(w.x);
        o[c * 8 + 2] = o[c * 8 + 2] * a + p * bflo(w.y); o[c * 8 + 3] = o[c * 8 + 3] * a + p * bfhi(w.y);
        o[c * 8 + 4] = o[c * 8 + 4] * a + p * bflo(w.z); o[c * 8 + 5] = o[c * 8 + 5] * a + p * bfhi(w.z);
        o[c * 8 + 6] = o[c * 8 + 6] * a + p * bflo(w.w); o[c * 8 + 7] = o[c * 8 + 7] * a + p * bfhi(w.w); }
}
__device__ __forceinline__ void gate_store64(const float (&o)[64], float l, const bf16* gate, bf16* y) {
    const float rl = 1.f / l;
#pragma unroll
    for (int c = 0; c < 8; ++c) { const v4u g = *(const GAS v4u*)(gate + c * 8); v4u w;
        w.x = pk2(o[c * 8 + 0] * rl * siluf_(bflo(g.x)), o[c * 8 + 1] * rl * siluf_(bfhi(g.x)));
        w.y = pk2(o[c * 8 + 2] * rl * siluf_(bflo(g.y)), o[c * 8 + 3] * rl * siluf_(bfhi(g.y)));
        w.z = pk2(o[c * 8 + 4] * rl * siluf_(bflo(g.z)), o[c * 8 + 5] * rl * siluf_(bfhi(g.z)));
        w.w = pk2(o[c * 8 + 6] * rl * siluf_(bflo(g.w)), o[c * 8 + 7] * rl * siluf_(bfhi(g.w)));
        *(GAS v4u*)(y + c * 8) = w; }
}

__device__ __forceinline__ void naive_even(const bf16* H, bf16* Y, int T, const float* t5, const float* sink, int gtid, int gstride) {
    for (int it = gtid; it < MC * 12; it += gstride) {
        const int hh = it / MC, tok = it - hh * MC, pos = tok % T, sb = tok - pos;
        float q[64], o[64], m, l;
#pragma unroll
        for (int d = 0; d < 64; ++d) o[d] = 0.f;
        const bf16* hrow = H + (size_t)tok * EVEN_IN;
        if (hh < 8) {
            load_row64(hrow + hh * 64, q, 0.125f);
            m = sink[hh]; l = 1.f;
            const int kvh = hh >> 2;
            for (int rel = -128; rel <= 128; ++rel) { const int kp = pos + rel; if (kp < 0 || kp >= T) continue;
                const bf16* kr = H + (size_t)(sb + kp) * EVEN_IN;
                attend(kr + 512 + kvh * 64, kr + 640 + kvh * 64, q, t5[t5_bucket(rel) * 20 + hh], m, l, o); }
            gate_store64(o, l, hrow + 3072 + hh * 64, Y + (size_t)tok * EVEN_OUT + hh * 64);
        } else {
            const int h = hh - 8; m = -INFINITY; l = 0.f;
            for (int g = 0; g < 3; ++g) { const int dil = g == 0 ? 1 : g == 1 ? 4 : 16;
                load_row64(hrow + 768 + g * 256 + h * 64, q, 0.125f);
                for (int j = -64; j <= 64; ++j) { const int kp = pos + dil * j; if (kp < 0 || kp >= T) continue;
                    const bf16* kr = H + (size_t)(sb + kp) * EVEN_IN;
                    attend(kr + 1536 + g * 256 + h * 64, kr + 2304 + g * 256 + h * 64, q, t5[t5_bucket(dil * j) * 20 + 8 + g * 4 + h], m, l, o); } }
            gate_store64(o, l, hrow + 3584 + h * 64, Y + (size_t)tok * EVEN_OUT + 512 + h * 64);
        }
    }
}
__device__ __forceinline__ void naive_na(const bf16* H, bf16* Y, int T, const float* rpb, int gtid, int gstride) {
    const int rows = T / 64;
    for (int it = gtid; it < MC * 8; it += gstride) {
        const int h = it / MC, tok = it - h * MC, pos = tok % T, sb = tok - pos, r = pos >> 6, c = pos & 63;
        const int sr = min(max(r - 4, 0), rows - 8), sc = min(max(c - 8, 0), 48);
        float q[64], o[64], m = -INFINITY, l = 0.f;
#pragma unroll
        for (int d = 0; d < 64; ++d) o[d] = 0.f;
        const bf16* hrow = H + (size_t)tok * ODD_IN;
        load_row64(hrow + h * 64, q, 0.125f);
        for (int kr = sr; kr < sr + 8; ++kr)
            for (int kc = sc; kc < sc + 16; ++kc) { const bf16* krow = H + (size_t)(sb + kr * 64 + kc) * ODD_IN;
                attend(krow + 512 + h * 64, krow + 1024 + h * 64, q, rpb[(h * 15 + (kr - r + 7)) * 31 + (kc - c + 15)], m, l, o); }
        gate_store64(o, l, hrow + 3584 + h * 64, Y + (size_t)tok * ODD_OUT + h * 64);
    }
}
__device__ __forceinline__ void naive_hgrn(const bf16* H, float* O, int T, int nseq, const float* lb_d, LAS unsigned char* lds, int tid, int bid, int G) {
    LAS float* Fs = (LAS float*)lds; LAS float* Qs = Fs + 32 * 128; LAS float* Vs = Qs + 32 * 128; LAS float* Op = Vs + 32 * 128;
    const int dkg = tid >> 7, dv = tid & 127;
    for (int ch = bid; ch < nseq * 8; ch += G) {
        const int seq = ch >> 3, dir = (ch >> 2) & 1, head = ch & 3;
        float S[32];
#pragma unroll
        for (int i = 0; i < 32; ++i) S[i] = 0.f;
        const int zcol = 2560 + dir * 512 + head * 128;
        for (int t0 = 0; t0 < T; t0 += 32) {
            for (int e = tid; e < 32 * 128; e += 512) { const int tt = e >> 7, c = e & 127; const int t = t0 + tt, pos = dir ? T - 1 - t : t;
                const bf16* hr = H + (size_t)(seq * T + pos) * ODD_IN;
                const float a0 = lb_d[(dir * 2 + 0) * 512 + head * 128 + c], a1 = lb_d[(dir * 2 + 1) * 512 + head * 128 + c];
                const float lb = sigmoidf_(a1 - a0);
                Fs[e] = lb + (1.f - lb) * sigmoidf_(bf2f(hr[zcol + c])); Qs[e] = bf2f(hr[1536 + head * 128 + c]); Vs[e] = bf2f(hr[2048 + head * 128 + c]); }
            __syncthreads();
            for (int tt = 0; tt < 32; ++tt) { const float v = Vs[tt * 128 + dv]; float acc = 0.f;
#pragma unroll
                for (int i = 0; i < 32; ++i) { const float ff = Fs[tt * 128 + dkg * 32 + i]; S[i] = ff * S[i] + (1.f - ff) * v; acc += Qs[tt * 128 + dkg * 32 + i] * S[i]; }
                Op[(tt * 4 + dkg) * 128 + dv] = acc; }
            __syncthreads();
            for (int e = tid; e < 32 * 128; e += 512) { const int tt = e >> 7, c = e & 127; const int t = t0 + tt, pos = dir ? T - 1 - t : t;
                O[((size_t)dir * MC + seq * T + pos) * 512 + head * 128 + c] = (Op[(tt * 4 + 0) * 128 + c] + Op[(tt * 4 + 1) * 128 + c]) + (Op[(tt * 4 + 2) * 128 + c] + Op[(tt * 4 + 3) * 128 + c]); }
            __syncthreads();
        }
    }
}
__device__ __forceinline__ void hgrn_combine(const bf16* H, const float* O, bf16* Y, const float* gnorm, int gw, int NGW, int lane) {
    for (int it = gw; it < MC * 2; it += NGW) { const int tok = it >> 1, col = (it & 1) * 256 + lane * 4;
        const f32x4 a = *(const GAS f32x4*)(O + (size_t)tok * 512 + col), b = *(const GAS f32x4*)(O + ((size_t)MC + tok) * 512 + col);
        const f32x4 od = a + b; float ss = od.x * od.x + od.y * od.y + od.z * od.z + od.w * od.w;
#pragma unroll
        for (int o = 1; o < 32; o <<= 1) ss += __shfl_xor(ss, o);
        const float r = 1.f / sqrtf(ss * (1.f / 128.f) + RMS_EPS);
        const f32x4 gn = *(const GAS f32x4*)(gnorm + col);
        const unsigned long long gg = *(const GAS unsigned long long*)(H + (size_t)tok * ODD_IN + 4096 + col);
        const unsigned g0 = (unsigned)gg, g1 = (unsigned)(gg >> 32);
        const unsigned long long w = (unsigned long long)pk2(od.x * r * gn.x * siluf_(bflo(g0)), od.y * r * gn.y * siluf_(bfhi(g0)))
                                   | ((unsigned long long)pk2(od.z * r * gn.z * siluf_(bflo(g1)), od.w * r * gn.w * siluf_(bfhi(g1))) << 32);
        *(GAS unsigned long long*)(Y + (size_t)tok * ODD_OUT + 512 + col) = w; }
}
__device__ __forceinline__ void ln_row(const float* zrow, const float* g, const float* b, float* outf, bf16* outb, int lane) {
    const GAS f32x4* xr = (const GAS f32x4*)zrow + lane;
    f32x4 v[4]; float s = 0.f;
#pragma unroll
    for (int j = 0; j < 4; ++j) { v[j] = xr[64 * j]; s += (v[j].x + v[j].y) + (v[j].z + v[j].w); }
    const float mean = wave_sum(s) * (1.f / DM); float s2 = 0.f;
#pragma unroll
    for (int j = 0; j < 4; ++j) { v[j] = v[j] - mean; s2 += (v[j].x * v[j].x + v[j].y * v[j].y) + (v[j].z * v[j].z + v[j].w * v[j].w); }
    const float rstd = 1.f / sqrtf(wave_sum(s2) * (1.f / DM) + LN_EPS);
#pragma unroll
    for (int j = 0; j < 4; ++j) { const f32x4 gg = *((const GAS f32x4*)g + lane + 64 * j), bb = *((const GAS f32x4*)b + lane + 64 * j);
        const f32x4 o = v[j] * rstd * gg + bb;
        *((GAS f32x4*)outf + lane + 64 * j) = o;
        if (outb) *((GAS unsigned long long*)outb + lane + 64 * j) = (unsigned long long)pk2(o.x, o.y) | ((unsigned long long)pk2(o.z, o.w) << 32); }
}


typedef float f32x16 __attribute__((ext_vector_type(16)));
typedef short s16x4 __attribute__((ext_vector_type(4)));
typedef float f32x2_t __attribute__((ext_vector_type(2)));
typedef __bf16 bf16x2_t __attribute__((ext_vector_type(2)));
constexpr float L2E = 1.4426950408889634f, QSC = 0.125f * L2E;
__device__ __forceinline__ unsigned cvtpk(float lo, float hi) { f32x2_t v = {lo, hi}; bf16x2_t b = __builtin_convertvector(v, bf16x2_t); return __builtin_bit_cast(unsigned, b); }
__device__ __forceinline__ s16x4 vtr(LAS unsigned char* p) { return __builtin_bit_cast(s16x4, __builtin_amdgcn_ds_read_tr16_b64_v4i16((LAS s16x4*)p)); }
__device__ __forceinline__ float xhalf_max(float v) { auto rr = __builtin_amdgcn_permlane32_swap(__float_as_uint(v), __float_as_uint(v), false, false); return fmaxf(__uint_as_float(rr[0]), __uint_as_float(rr[1])); }
__device__ __forceinline__ float xhalf_sum(float v) { auto rr = __builtin_amdgcn_permlane32_swap(__float_as_uint(v), __float_as_uint(v), false, false); return __uint_as_float(rr[0]) + __uint_as_float(rr[1]); }
struct AttnSt { f32x16 o0, o1; float m, l; };

template <class RowF, class FixF>
__device__ __forceinline__ void attn_run(AttnSt& st, const bf16x8 (&qf)[4], int t_lo, int t_hi, int kcol, int vcol, RowF rowf, FixF fixf, LAS unsigned char* vl, int lane) {
    const int kvi = lane & 31, hi = lane >> 5;
    bf16x8 kn[4]; v4u vn[4];
#define ATT_LOAD(t_) do { const bf16* kr_ = rowf((t_), kvi) + kcol + 8 * hi; \
        _Pragma("unroll") for (int d0 = 0; d0 < 4; ++d0) kn[d0] = *(const GAS bf16x8*)(kr_ + d0 * 16); \
        _Pragma("unroll") for (int i = 0; i < 4; ++i) vn[i] = *(const GAS v4u*)(rowf((t_), i * 8 + (lane >> 3)) + vcol + (lane & 7) * 8); } while (0)
    if (t_lo < t_hi) ATT_LOAD(t_lo);
    LAS unsigned char* vw = vl + ((lane & 7) >> 2) * 2048 + (lane >> 3) * 64 + (lane & 3) * 16;
    LAS unsigned char* vr = vl + (4 * hi + ((lane & 15) >> 2)) * 64 + (16 * ((lane >> 4) & 1) + 4 * (lane & 3)) * 2;
    for (int t = t_lo; t < t_hi; ++t) {
        bf16x8 kf[4]; v4u vv[4];
#pragma unroll
        for (int i = 0; i < 4; ++i) { kf[i] = kn[i]; vv[i] = vn[i]; }
        if (t + 1 < t_hi) ATT_LOAD(t + 1);
#pragma unroll
        for (int i = 0; i < 4; ++i) *(LAS v4u*)(vw + i * 512) = vv[i];
        f32x16 s = {0.f, 0.f, 0.f, 0.f, 0.f, 0.f, 0.f, 0.f, 0.f, 0.f, 0.f, 0.f, 0.f, 0.f, 0.f, 0.f};
#pragma unroll
        for (int d0 = 0; d0 < 4; ++d0) s = __builtin_amdgcn_mfma_f32_32x32x16_bf16(kf[d0], qf[d0], s, 0, 0, 0);
        fixf(t, s);
        float mx = fmaxf(s[0], s[1]);
#pragma unroll
        for (int r = 2; r < 16; ++r) mx = fmaxf(mx, s[r]);
        mx = xhalf_max(mx);
        const float mn = fmaxf(st.m, mx), sc = __builtin_amdgcn_exp2f(st.m - mn);
        st.m = mn;
        float sum = 0.f;
#pragma unroll
        for (int r = 0; r < 16; ++r) { s[r] = __builtin_amdgcn_exp2f(s[r] - mn); sum += s[r]; }
        st.l = st.l * sc + sum;
        st.o0 = st.o0 * sc; st.o1 = st.o1 * sc;
        v4u p0, p1;
        p0.x = cvtpk(s[0], s[1]); p0.y = cvtpk(s[2], s[3]); p0.z = cvtpk(s[4], s[5]); p0.w = cvtpk(s[6], s[7]);
        p1.x = cvtpk(s[8], s[9]); p1.y = cvtpk(s[10], s[11]); p1.z = cvtpk(s[12], s[13]); p1.w = cvtpk(s[14], s[15]);
        const bf16x8 pf0 = __builtin_bit_cast(bf16x8, p0), pf1 = __builtin_bit_cast(bf16x8, p1);
        __builtin_amdgcn_wave_barrier();
#pragma unroll
        for (int d0 = 0; d0 < 2; ++d0) {
            const s16x4 a0 = vtr(vr + d0 * 2048), a1 = vtr(vr + d0 * 2048 + 512), b0 = vtr(vr + d0 * 2048 + 1024), b1 = vtr(vr + d0 * 2048 + 1536);
            const bf16x8 vf0 = (bf16x8){a0[0], a0[1], a0[2], a0[3], a1[0], a1[1], a1[2], a1[3]}, vf1 = (bf16x8){b0[0], b0[1], b0[2], b0[3], b1[0], b1[1], b1[2], b1[3]};
            if (d0 == 0) { st.o0 = __builtin_amdgcn_mfma_f32_32x32x16_bf16(vf0, pf0, st.o0, 0, 0, 0); st.o0 = __builtin_amdgcn_mfma_f32_32x32x16_bf16(vf1, pf1, st.o0, 0, 0, 0); }
            else         { st.o1 = __builtin_amdgcn_mfma_f32_32x32x16_bf16(vf0, pf0, st.o1, 0, 0, 0); st.o1 = __builtin_amdgcn_mfma_f32_32x32x16_bf16(vf1, pf1, st.o1, 0, 0, 0); }
        }
        __builtin_amdgcn_wave_barrier();
    }
#undef ATT_LOAD
}
__device__ __forceinline__ void attn_store(const AttnSt& st, const bf16* gate_row, bf16* y_row, int lane) {
    const int hi = lane >> 5; const float rl = 1.f / xhalf_sum(st.l);
#pragma unroll
    for (int d0 = 0; d0 < 2; ++d0)
#pragma unroll
        for (int g = 0; g < 4; ++g) { const int d = 32 * d0 + 8 * g + 4 * hi;
            const unsigned long long gg = *(const GAS unsigned long long*)(gate_row + d); const unsigned g0 = (unsigned)gg, g1 = (unsigned)(gg >> 32);
            const float a = (d0 ? st.o1[4 * g + 0] : st.o0[4 * g + 0]) * rl, b = (d0 ? st.o1[4 * g + 1] : st.o0[4 * g + 1]) * rl, c = (d0 ? st.o1[4 * g + 2] : st.o0[4 * g + 2]) * rl, e = (d0 ? st.o1[4 * g + 3] : st.o0[4 * g + 3]) * rl;
            *(GAS unsigned long long*)(y_row + d) = (unsigned long long)cvtpk(a * siluf_(bflo(g0)), b * siluf_(bfhi(g0))) | ((unsigned long long)cvtpk(c * siluf_(bflo(g1)), e * siluf_(bfhi(g1))) << 32); }
}
__device__ __forceinline__ void load_q(bf16x8 (&qf)[4], const bf16* qrow, int lane) {
#pragma unroll
    for (int d0 = 0; d0 < 4; ++d0) qf[d0] = *(const GAS bf16x8*)(qrow + d0 * 16 + 8 * (lane >> 5));
}
#define CROW(r, hi) (((r) & 3) + 8 * ((r) >> 2) + 4 * (hi))

constexpr int TA_OFF = 0, TA_N = 320;
constexpr int TB2_OFF = 10240, TB2_N = 192;
constexpr int TB1_OFF = 13312, TB1_N = 384;
constexpr int TB0_OFF = 19456, TB0_N = 1152;
constexpr int VT_OFF = 40960;
__device__ __forceinline__ void even_tables(LAS unsigned char* lds, const float* t5, int tid) {
    LAS float* ta = (LAS float*)(lds + TA_OFF); LAS float* tb2 = (LAS float*)(lds + TB2_OFF); LAS float* tb1 = (LAS float*)(lds + TB1_OFF); LAS float* tb0 = (LAS float*)(lds + TB0_OFF);
    for (int e = tid; e < 8 * TA_N; e += 512) { const int h = e / TA_N, rel = e % TA_N - 160; ta[e] = (rel >= -128 && rel <= 128) ? t5[t5_bucket(rel) * 20 + h] * L2E : -INFINITY; }
    for (int e = tid; e < 4 * TB2_N; e += 512) { const int h = e / TB2_N, rel = e % TB2_N - 96; tb2[e] = (rel >= -64 && rel <= 64) ? t5[t5_bucket(16 * rel) * 20 + 16 + h] * L2E : -INFINITY; }
    for (int e = tid; e < 4 * TB1_N; e += 512) { const int h = e / TB1_N, rel = e % TB1_N - 192; tb1[e] = (rel >= -64 && rel <= 64) ? t5[t5_bucket(4 * rel) * 20 + 12 + h] * L2E : -INFINITY; }
    for (int e = tid; e < 4 * TB0_N; e += 512) { const int h = e / TB0_N, rel = e % TB0_N - 576; tb0[e] = (rel >= -64 && rel <= 64) ? t5[t5_bucket(rel) * 20 + 8 + h] * L2E : -INFINITY; }
}
__device__ __forceinline__ void mixA_task(const bf16* H, bf16* Y, int T, const float* sink, LAS unsigned char* lds, LAS unsigned char* vl, int qt, int hh, int lane) {
    const int tok0 = qt * 32, pos0 = tok0 % T, sb = tok0 - pos0, qi = lane & 31, hi = lane >> 5, kvh = hh >> 2;
    bf16x8 qf[4]; load_q(qf, H + (size_t)(tok0 + qi) * EVEN_IN + hh * 64, lane);
    AttnSt st; st.m = sink[hh] * L2E; st.l = hi == 0 ? 1.f : 0.f;
#pragma unroll
    for (int r = 0; r < 16; ++r) { st.o0[r] = 0.f; st.o1[r] = 0.f; }
    const int t_lo = pos0 < 128 ? (128 - pos0) / 32 : 0, t_hi = min(9, (T - pos0 + 128) / 32);
    const LAS float* tab = (const LAS float*)(lds + TA_OFF) + hh * TA_N + 160 - 128 - qi + 4 * hi;
    auto rowf = [&](int t, int kvi) -> const bf16* { return H + (size_t)(sb + pos0 - 128 + 32 * t + kvi) * EVEN_IN; };
    auto fixf = [&](int t, f32x16& s) {
#pragma unroll
        for (int r = 0; r < 16; ++r) s[r] = s[r] * QSC + tab[32 * t + (r & 3) + 8 * (r >> 2)];
    };
    attn_run(st, qf, t_lo, t_hi, 512 + kvh * 64, 640 + kvh * 64, rowf, fixf, vl, lane);
    attn_store(st, H + (size_t)(tok0 + qi) * EVEN_IN + 3072 + hh * 64, Y + (size_t)(tok0 + qi) * EVEN_OUT + hh * 64, lane);
}
__device__ __forceinline__ void mixB_task(const bf16* H, bf16* Y, int T, LAS unsigned char* lds, LAS unsigned char* vl, int qt, int h, int lane) {
    const int per_seq = T / 32, seq = qt / per_seq, w = qt - seq * per_seq, r16 = w & 15, i0 = (w >> 4) * 32, sb = seq * T, qi = lane & 31, hi = lane >> 5;
    const int qpos = r16 + 16 * (i0 + qi); const size_t qrow = (size_t)(sb + qpos) * EVEN_IN;
    AttnSt st; st.m = -1e30f; st.l = 0.f;
#pragma unroll
    for (int r = 0; r < 16; ++r) { st.o0[r] = 0.f; st.o1[r] = 0.f; }
    bf16x8 qf[4];
    {
        load_q(qf, H + qrow + 768 + 2 * 256 + h * 64, lane);
        const int L = T / 16, kb = i0 - 64, t_lo = kb < 0 ? (-kb) / 32 : 0, t_hi = min(5, (L - kb) / 32);
        const LAS float* tab = (const LAS float*)(lds + TB2_OFF) + h * TB2_N + 96 - 64 - qi + 4 * hi;
        auto rowf = [&](int t, int kvi) -> const bf16* { return H + (size_t)(sb + r16 + 16 * (kb + 32 * t + kvi)) * EVEN_IN; };
        auto fixf = [&](int t, f32x16& s) {
#pragma unroll
            for (int r = 0; r < 16; ++r) s[r] = s[r] * QSC + tab[32 * t + (r & 3) + 8 * (r >> 2)]; };
        attn_run(st, qf, t_lo, t_hi, 1536 + 2 * 256 + h * 64, 2304 + 2 * 256 + h * 64, rowf, fixf, vl, lane);
    }
    {
        load_q(qf, H + qrow + 768 + 1 * 256 + h * 64, lane);
        const int L = T / 4, kb = 4 * i0 - 64, t_lo = kb < 0 ? (-kb) / 32 : 0, t_hi = min(8, (L - kb) / 32), r4 = r16 & 3;
        const LAS float* tab = (const LAS float*)(lds + TB1_OFF) + h * TB1_N + 192 - 64 - (r16 >> 2) - 4 * qi + 4 * hi;
        auto rowf = [&](int t, int kvi) -> const bf16* { return H + (size_t)(sb + r4 + 4 * (kb + 32 * t + kvi)) * EVEN_IN; };
        auto fixf = [&](int t, f32x16& s) {
#pragma unroll
            for (int r = 0; r < 16; ++r) s[r] = s[r] * QSC + tab[32 * t + (r & 3) + 8 * (r >> 2)]; };
        attn_run(st, qf, t_lo, t_hi, 1536 + 1 * 256 + h * 64, 2304 + 1 * 256 + h * 64, rowf, fixf, vl, lane);
    }
    {
        load_q(qf, H + qrow + 768 + h * 64, lane);
        const int kb = 16 * i0 - 64, t_lo = kb < 0 ? (-kb) / 32 : 0, t_hi = min(20, (T - kb) / 32);
        const LAS float* tab = (const LAS float*)(lds + TB0_OFF) + h * TB0_N + 576 - 64 - r16 - 16 * qi + 4 * hi;
        auto rowf = [&](int t, int kvi) -> const bf16* { return H + (size_t)(sb + kb + 32 * t + kvi) * EVEN_IN; };
        auto fixf = [&](int t, f32x16& s) {
#pragma unroll
            for (int r = 0; r < 16; ++r) s[r] = s[r] * QSC + tab[32 * t + (r & 3) + 8 * (r >> 2)]; };
        attn_run(st, qf, t_lo, t_hi, 1536 + h * 64, 2304 + h * 64, rowf, fixf, vl, lane);
    }
    attn_store(st, H + qrow + 3584 + h * 64, Y + (size_t)(sb + qpos) * EVEN_OUT + 512 + h * 64, lane);
}
__device__ __forceinline__ void odd_tables(LAS unsigned char* lds, const float* rpb, int tid) {
    LAS float* tc = (LAS float*)lds;
    for (int e = tid; e < 8 * 465; e += 512) tc[e] = rpb[e] * L2E;
}
__device__ __forceinline__ void mixC_task(const bf16* H, bf16* Y, int T, LAS unsigned char* lds, LAS unsigned char* vl, int qt, int h, int lane) {
    const int tok0 = qt * 32, pos0 = tok0 % T, sb = tok0 - pos0, gr = pos0 >> 6, c0 = pos0 & 63, rows = T >> 6, qi = lane & 31, hi = lane >> 5;
    const int sr = min(max(gr - 4, 0), rows - 8), kc0 = c0 ? 24 : 0, qc = c0 + qi, sc = min(max(qc - 8, 0), 48);
    bf16x8 qf[4]; load_q(qf, H + (size_t)(tok0 + qi) * ODD_IN + h * 64, lane);
    AttnSt st; st.m = -1e30f; st.l = 0.f;
#pragma unroll
    for (int r = 0; r < 16; ++r) { st.o0[r] = 0.f; st.o1[r] = 0.f; }
    const LAS float* tab = (const LAS float*)lds + h * 465 + (sr - gr + 7) * 31 + 15 - qc;
    auto rowf = [&](int t, int kvi) -> const bf16* { const int e = 32 * t + kvi, kr = (e * 205) >> 13, kc = e - 40 * kr; return H + (size_t)(sb + (sr + kr) * 64 + kc0 + kc) * ODD_IN; };
    auto fixf = [&](int t, f32x16& s) {
#pragma unroll
        for (int r = 0; r < 16; ++r) { const int e = 32 * t + (r & 3) + 8 * (r >> 2) + 4 * hi, kr = (e * 205) >> 13, kc = kc0 + e - 40 * kr;
            const bool ok = (unsigned)(kc - sc) < 16u; const int dc = min(max(kc - qc, -15), 15) + qc;
            const float v = s[r] * QSC + tab[kr * 31 + dc]; s[r] = ok ? v : -INFINITY; }
    };
    attn_run(st, qf, 0, 10, 512 + h * 64, 1024 + h * 64, rowf, fixf, vl, lane);
    attn_store(st, H + (size_t)(tok0 + qi) * ODD_IN + 3584 + h * 64, Y + (size_t)(tok0 + qi) * ODD_OUT + h * 64, lane);
}

constexpr int HG_RP = 272;
constexpr int HG_QI = 0, HG_KI = 64 * HG_RP, HG_VV = 2 * 64 * HG_RP, HG_EREF = 3 * 64 * HG_RP, HG_EEND = HG_EREF + 512, HG_DD = HG_EEND + 512, HG_TOT = HG_DD + 512, HG_REGION = HG_TOT + 1024;
static_assert(2 * HG_REGION <= RING_BYTES, "hgrn LDS");
constexpr int SEG = 512, SEGCH = SEG / 64;
template <int MODE>
__device__ __forceinline__ void hgrn_seg_task(const bf16* H, float* O, float* SLOC, const float* SINIT, float* DTOT, const float* lb_d, int T, LAS unsigned char* lds, int task, int tid) {
    const int hp = task & 1, dir = (task >> 1) & 1, sg = task >> 2, tokbase = sg * SEG;
    const int lane = tid & 63, w = __builtin_amdgcn_readfirstlane(tid >> 6);
    const int hd = tid >> 8, half = (tid >> 7) & 1, ch = tid & 127, headp = hp * 2 + hd;
    const float lb = sigmoidf_(lb_d[(dir * 2 + 1) * 512 + headp * 128 + ch] - lb_d[(dir * 2) * 512 + headp * 128 + ch]);
    const int zc = 2560 + dir * 512 + headp * 128 + ch, qc = 1536 + headp * 128 + ch, ic = 2048 + headp * 128 + ch;
    LAS unsigned char* P = lds + hd * HG_REGION;
    const int mhd = w >> 2, j = w & 3, mhead = hp * 2 + mhd, c31 = lane & 31, hi = lane >> 5;
    LAS unsigned char* R = lds + mhd * HG_REGION;
    const size_t sidx = (size_t)((sg * 2 + dir) * 4 + mhead) * 16384 + (size_t)(j * 4) * 1024 + lane;
    f32x16 S[4];
#pragma unroll
    for (int i = 0; i < 4; ++i)
#pragma unroll
        for (int r = 0; r < 16; ++r) S[i][r] = MODE ? SINIT[sidx + (i * 16 + r) * 64] : 0.f;
    float dtot = 1.f;
    const int trq = (lane & 15) >> 2, trc = (16 * ((lane >> 4) & 1) + 4 * (lane & 3)) * 2;
    for (int c = 0; c < SEGCH; ++c) {
        { const int t256 = tid & 255, rr = t256 >> 4, cc = (t256 & 15) * 8;
          v4u rz[4], rq[4], ri[4];
#pragma unroll
          for (int p = 0; p < 4; ++p) { const int tau = p * 16 + rr, u = c * 64 + tau, tok = tokbase + (dir ? SEG - 1 - u : u); const bf16* row = H + (size_t)tok * ODD_IN + headp * 128 + cc;
              rz[p] = *(const GAS v4u*)(row + 2560 + dir * 512); rq[p] = *(const GAS v4u*)(row + 1536); ri[p] = *(const GAS v4u*)(row + 2048); }
#pragma unroll
          for (int p = 0; p < 4; ++p) { const int tau = p * 16 + rr;
              *(LAS v4u*)(P + HG_KI + tau * HG_RP + cc * 2) = rz[p]; *(LAS v4u*)(P + HG_QI + tau * HG_RP + cc * 2) = rq[p]; *(LAS v4u*)(P + HG_VV + tau * HG_RP + cc * 2) = ri[p]; } }
        __syncthreads();
        float bp[32], om[32], qv[32]; float run = 0.f;
#pragma unroll
        for (int tt = 0; tt < 32; ++tt) { const int tau = 32 * half + tt;
            const float zz = bf2f(*(const LAS bf16*)(P + HG_KI + tau * HG_RP + ch * 2));
            const float f = lb + (1.f - lb) * __builtin_amdgcn_rcpf(1.f + __expf(-zz));
            run += __logf(f); bp[tt] = run; om[tt] = 1.f - f; qv[tt] = bf2f(*(const LAS bf16*)(P + HG_QI + tau * HG_RP + ch * 2)); }
        ((LAS float*)(P + HG_TOT))[half * 128 + ch] = run;
        __syncthreads();
        const float t0 = ((LAS float*)(P + HG_TOT))[ch], t1 = ((LAS float*)(P + HG_TOT))[128 + ch];
#pragma unroll
        for (int tt = 0; tt < 32; ++tt) { const int tau = 32 * half + tt; const float d = bp[tt] + (half ? t0 : 0.f) - t0;
            const float qi = qv[tt] * __expf(fminf(d, 80.f)), ki = om[tt] * __expf(fminf(-d, 80.f));
            *(LAS bf16*)(P + HG_QI + tau * HG_RP + ch * 2) = (bf16)f2bf(qi); *(LAS bf16*)(P + HG_KI + tau * HG_RP + ch * 2) = (bf16)f2bf(ki); }
        if (half == 0) { const float dd = __expf(t0 + t1); ((LAS float*)(P + HG_EREF))[ch] = __expf(t0); ((LAS float*)(P + HG_EEND))[ch] = __expf(t1); ((LAS float*)(P + HG_DD))[ch] = dd; dtot *= dd; }
        __syncthreads();
        if (MODE) {
            f32x16 ot0, ot1;
#pragma unroll
            for (int r = 0; r < 16; ++r) { ot0[r] = 0.f; ot1[r] = 0.f; }
#define HG_ATT(a_, b_, dst) do { dst = (f32x16){0.f,0.f,0.f,0.f,0.f,0.f,0.f,0.f,0.f,0.f,0.f,0.f,0.f,0.f,0.f,0.f}; \
            _Pragma("unroll") for (int k = 0; k < 8; ++k) { const bf16x8 ka_ = *(const LAS bf16x8*)(R + HG_KI + (32 * (a_) + c31) * HG_RP + (k * 16 + 8 * hi) * 2), qb_ = *(const LAS bf16x8*)(R + HG_QI + (32 * (b_) + c31) * HG_RP + (k * 16 + 8 * hi) * 2); \
                dst = __builtin_amdgcn_mfma_f32_32x32x16_bf16(ka_, qb_, dst, 0, 0, 0); } } while (0)
#define HG_PV(a_, t_, acc_) do { v4u p0_, p1_; p0_.x = cvtpk(t_[0], t_[1]); p0_.y = cvtpk(t_[2], t_[3]); p0_.z = cvtpk(t_[4], t_[5]); p0_.w = cvtpk(t_[6], t_[7]); \
            p1_.x = cvtpk(t_[8], t_[9]); p1_.y = cvtpk(t_[10], t_[11]); p1_.z = cvtpk(t_[12], t_[13]); p1_.w = cvtpk(t_[14], t_[15]); \
            LAS unsigned char* vb_ = R + HG_VV + (32 * (a_) + 4 * hi + trq) * HG_RP + 64 * j + trc; \
            const s16x4 a0_ = vtr(vb_), a1_ = vtr(vb_ + 8 * HG_RP), b0_ = vtr(vb_ + 16 * HG_RP), b1_ = vtr(vb_ + 24 * HG_RP); \
            acc_ = __builtin_amdgcn_mfma_f32_32x32x16_bf16((bf16x8){a0_[0], a0_[1], a0_[2], a0_[3], a1_[0], a1_[1], a1_[2], a1_[3]}, __builtin_bit_cast(bf16x8, p0_), acc_, 0, 0, 0); \
            acc_ = __builtin_amdgcn_mfma_f32_32x32x16_bf16((bf16x8){b0_[0], b0_[1], b0_[2], b0_[3], b1_[0], b1_[1], b1_[2], b1_[3]}, __builtin_bit_cast(bf16x8, p1_), acc_, 0, 0, 0); } while (0)
            f32x16 t;
            HG_ATT(0, 0, t);
#pragma unroll
            for (int r = 0; r < 16; ++r) t[r] = (CROW(r, hi) <= c31) ? t[r] : 0.f;
            HG_PV(0, t, ot0);
            HG_ATT(0, 1, t);
            HG_PV(0, t, ot1);
            HG_ATT(1, 1, t);
#pragma unroll
            for (int r = 0; r < 16; ++r) t[r] = (CROW(r, hi) <= c31) ? t[r] : 0.f;
            HG_PV(1, t, ot1);
#undef HG_ATT
#undef HG_PV
#pragma unroll
            for (int i = 0; i < 4; ++i) {
                const f32x4 e0 = *(const LAS f32x4*)(R + HG_EREF + (32 * i + 4 * hi) * 4), e1 = *(const LAS f32x4*)(R + HG_EREF + (32 * i + 4 * hi + 8) * 4),
                            e2 = *(const LAS f32x4*)(R + HG_EREF + (32 * i + 4 * hi + 16) * 4), e3 = *(const LAS f32x4*)(R + HG_EREF + (32 * i + 4 * hi + 24) * 4);
                v4u a0, a1;
                a0.x = cvtpk(S[i][0] * e0.x, S[i][1] * e0.y); a0.y = cvtpk(S[i][2] * e0.z, S[i][3] * e0.w); a0.z = cvtpk(S[i][4] * e1.x, S[i][5] * e1.y); a0.w = cvtpk(S[i][6] * e1.z, S[i][7] * e1.w);
                a1.x = cvtpk(S[i][8] * e2.x, S[i][9] * e2.y); a1.y = cvtpk(S[i][10] * e2.z, S[i][11] * e2.w); a1.z = cvtpk(S[i][12] * e3.x, S[i][13] * e3.y); a1.w = cvtpk(S[i][14] * e3.z, S[i][15] * e3.w);
#pragma unroll
                for (int ks = 0; ks < 2; ++ks) { const bf16x8 af = __builtin_bit_cast(bf16x8, ks ? a1 : a0);
#pragma unroll
                    for (int b = 0; b < 2; ++b) { LAS unsigned char* qb = R + HG_QI + (32 * b + c31) * HG_RP + (32 * i + 16 * ks + 4 * hi) * 2;
                        const s16x4 lo = *(const LAS s16x4*)qb, hh_ = *(const LAS s16x4*)(qb + 16);
                        const bf16x8 bfm = (bf16x8){lo[0], lo[1], lo[2], lo[3], hh_[0], hh_[1], hh_[2], hh_[3]};
                        if (b == 0) ot0 = __builtin_amdgcn_mfma_f32_32x32x16_bf16(af, bfm, ot0, 0, 0, 0); else ot1 = __builtin_amdgcn_mfma_f32_32x32x16_bf16(af, bfm, ot1, 0, 0, 0); } }
            }
#pragma unroll
            for (int b = 0; b < 2; ++b) { const int u = c * 64 + 32 * b + c31, tok = tokbase + (dir ? SEG - 1 - u : u);
                float* op = O + ((size_t)dir * MC + tok) * 512 + mhead * 128 + 32 * j + 4 * hi;
#pragma unroll
                for (int g = 0; g < 4; ++g) { f32x4 v; if (b == 0) v = (f32x4){ot0[4 * g], ot0[4 * g + 1], ot0[4 * g + 2], ot0[4 * g + 3]}; else v = (f32x4){ot1[4 * g], ot1[4 * g + 1], ot1[4 * g + 2], ot1[4 * g + 3]};
                    *(GAS f32x4*)(op + 8 * g) = v; } }
        }
#pragma unroll
        for (int i = 0; i < 4; ++i) {
            f32x16 U = {0.f,0.f,0.f,0.f,0.f,0.f,0.f,0.f,0.f,0.f,0.f,0.f,0.f,0.f,0.f,0.f};
#pragma unroll
            for (int k4 = 0; k4 < 4; ++k4) {
                LAS unsigned char* kb = R + HG_KI + (16 * k4 + 4 * hi + trq) * HG_RP + 64 * i + trc;
                LAS unsigned char* vb = R + HG_VV + (16 * k4 + 4 * hi + trq) * HG_RP + 64 * j + trc;
                const s16x4 ka = vtr(kb), kb2 = vtr(kb + 8 * HG_RP), va = vtr(vb), vb2 = vtr(vb + 8 * HG_RP);
                U = __builtin_amdgcn_mfma_f32_32x32x16_bf16((bf16x8){ka[0], ka[1], ka[2], ka[3], kb2[0], kb2[1], kb2[2], kb2[3]}, (bf16x8){va[0], va[1], va[2], va[3], vb2[0], vb2[1], vb2[2], vb2[3]}, U, 0, 0, 0);
            }
#pragma unroll
            for (int g = 0; g < 4; ++g) { const f32x4 dd = *(const LAS f32x4*)(R + HG_DD + (32 * i + 4 * hi + 8 * g) * 4), ee = *(const LAS f32x4*)(R + HG_EEND + (32 * i + 4 * hi + 8 * g) * 4);
                S[i][4 * g + 0] = dd.x * S[i][4 * g + 0] + ee.x * U[4 * g + 0]; S[i][4 * g + 1] = dd.y * S[i][4 * g + 1] + ee.y * U[4 * g + 1];
                S[i][4 * g + 2] = dd.z * S[i][4 * g + 2] + ee.z * U[4 * g + 2]; S[i][4 * g + 3] = dd.w * S[i][4 * g + 3] + ee.w * U[4 * g + 3]; }
        }
        __syncthreads();
    }
    if (!MODE) {
#pragma unroll
        for (int i = 0; i < 4; ++i)
#pragma unroll
            for (int r = 0; r < 16; ++r) SLOC[sidx + (i * 16 + r) * 64] = S[i][r];
        if (half == 0) DTOT[(size_t)((sg * 2 + dir) * 4 + headp) * 128 + ch] = dtot;
    }
}
__device__ __forceinline__ void hgrn_scan(const float* SLOC, float* SINIT, const float* DTOT, int T, int nseq, int gtid, int gstride) {
    const int nsegs = T / SEG;
    for (int it = gtid; it < nseq * 8 * 16384; it += gstride) { const int e = it & 16383, sdh = it >> 14, head = sdh & 3, dir = (sdh >> 2) & 1, seq = sdh >> 3;
        const int ln = e & 63, r = (e >> 6) & 15, i = (e >> 10) & 3, dk = 32 * i + CROW(r, ln >> 5);
        float run = 0.f;
        for (int k = 0; k < nsegs; ++k) { const int ss = dir ? nsegs - 1 - k : k; const size_t hid = (size_t)(((seq * nsegs + ss) * 2 + dir) * 4 + head);
            SINIT[hid * 16384 + e] = run; run = DTOT[hid * 128 + dk] * run + SLOC[hid * 16384 + e]; } }
}
constexpr int PARAM_OFF = LDSCTL_OFF + 512;
enum { P_XP = 0, P_XS, P_T5, P_WIE, P_SINK, P_WOE, P_WIO, P_RPB, P_LBD, P_GN, P_WOO, P_LNG, P_LNB, P_OUT, P_WS, NPARAM };
template <class Tp> __device__ __forceinline__ Tp* ldp(LAS unsigned char* lds, int i) {
    volatile LAS unsigned* PB = (volatile LAS unsigned*)(lds + PARAM_OFF);
    const unsigned lo = __builtin_amdgcn_readfirstlane(PB[2 * i]), hi = __builtin_amdgcn_readfirstlane(PB[2 * i + 1]);
    return (Tp*)(((unsigned long long)hi << 32) | lo);
}
struct Ctx { int tid, lane, wave, bid, G, gtid, gstride, gw, NGW; };
__device__ __forceinline__ Ctx mkctx() {
    Ctx c; int t = threadIdx.x; asm volatile("" : "+v"(t));
    c.tid = t; c.lane = t & 63; c.wave = __builtin_amdgcn_readfirstlane(t >> 6); c.bid = blockIdx.x; c.G = gridDim.x;
    c.gtid = c.bid * (NWAVES * 64) + t; c.gstride = c.G * NWAVES * 64; c.gw = c.bid * NWAVES + c.wave; c.NGW = c.G * NWAVES; return c;
}
struct Chunk { int row0, T, nseq; bool is_p; };
__device__ __forceinline__ Chunk mkchunk(int c) { Chunk k; k.row0 = c * MC; k.is_p = k.row0 < NP_TOK; k.T = k.is_p ? T_P : T_S; k.nseq = MC / k.T; return k; }
__device__ __forceinline__ const float* chunk_x(LAS unsigned char* lds, const Chunk& k) {
    return k.is_p ? ldp<const float>(lds, P_XP) + (size_t)k.row0 * DM : ldp<const float>(lds, P_XS) + (size_t)(k.row0 - NP_TOK) * DM; }
__device__ __forceinline__ void grid_bar(LAS unsigned char* lds) {
    XcdBarrier b; b.bar = (unsigned*)(ldp<unsigned char>(lds, P_WS) + WS_CTL) + CW_BAR; b.x = xb_xcc_id(); b.st = (volatile LAS unsigned*)(lds + MISC_OFF) + 8;
    xcd_barrier(b);
}

__device__ __forceinline__ void ph_weights(LAS unsigned char* lds) {
    const Ctx x = mkctx(); unsigned char* ws = ldp<unsigned char>(lds, P_WS);
    LAS float* scr = (LAS float*)(lds + x.wave * 16384);
    constexpr int I1 = (DM / 64) * (EVEN_IN / 32), I2 = (EVEN_OUT / 64) * (DM / 32), I3 = (DM / 64) * (ODD_IN / 32), I4 = (ODD_OUT / 64) * (DM / 32);
    for (int it = x.gw; it < I1 + I2 + I3 + I4; it += x.NGW) {
        int r = it;
        if (r < I1) { p0_transpose_item(ldp<const float>(lds, P_WIE), DM, EVEN_IN, (bf16*)(ws + WS_W1), scr, r, x.lane); continue; } r -= I1;
        if (r < I2) { p0_transpose_item(ldp<const float>(lds, P_WOE), EVEN_OUT, DM, (bf16*)(ws + WS_W2), scr, r, x.lane); continue; } r -= I2;
        if (r < I3) { p0_transpose_item(ldp<const float>(lds, P_WIO), DM, ODD_IN, (bf16*)(ws + WS_W3), scr, r, x.lane); continue; } r -= I3;
        p0_transpose_item(ldp<const float>(lds, P_WOO), ODD_OUT, DM, (bf16*)(ws + WS_W4), scr, r, x.lane);
    }
}
__device__ __forceinline__ void ph_convert(LAS unsigned char* lds, int c) {
    const Ctx x = mkctx(); const Chunk k = mkchunk(c); const float* xin = chunk_x(lds, k); bf16* XB = (bf16*)(ldp<unsigned char>(lds, P_WS) + WS_XB);
    for (int i = x.gtid; i < MC * DM / 8; i += x.gstride) { const f32x4 a = ((const GAS f32x4*)xin)[2 * i], b = ((const GAS f32x4*)xin)[2 * i + 1];
        v4u w; w.x = pk2(a.x, a.y); w.y = pk2(a.z, a.w); w.z = pk2(b.x, b.y); w.w = pk2(b.z, b.w); ((GAS v4u*)XB)[i] = w; }
}
template <int WOFF, int N> __device__ __forceinline__ void ph_gemm_in(LAS unsigned char* lds) {
    unsigned char* ws = ldp<unsigned char>(lds, P_WS);
    pg8::Gemm g{(const pg8::bf16_t*)(ws + WS_XB), (const pg8::bf16_t*)(ws + WOFF), MC, N, DM}; pg8::StaticOrder S; S.init(MC, N, (int)gridDim.x, (int)blockIdx.x);
    pg8::EpiBf16<0> E{(pg8::bf16_t*)(ws + WS_H), N, nullptr, 0, 0, 1.f};
    pg8::gemm_phase<pg8::EpiBf16<0>, pg8::StaticOrder, true, true>(lds, g, S, E);
}
template <int WOFF, int K> __device__ __forceinline__ void ph_gemm_out(LAS unsigned char* lds, const float* base) {
    unsigned char* ws = ldp<unsigned char>(lds, P_WS);
    pg8::Gemm g{(const pg8::bf16_t*)(ws + WS_Y), (const pg8::bf16_t*)(ws + WOFF), MC, DM, K}; pg8::StaticOrder S; S.init(MC, DM, (int)gridDim.x, (int)blockIdx.x);
    EpiResF32 E{base, (float*)(ws + WS_Z), DM, ALPHA};
    pg8::gemm_phase<EpiResF32, pg8::StaticOrder, true, true>(lds, g, S, E);
}
__device__ __forceinline__ void ph_ln(LAS unsigned char* lds, int c, int layer, bool to_bf16) {
    const Ctx x = mkctx(); const Chunk k = mkchunk(c); unsigned char* ws = ldp<unsigned char>(lds, P_WS);
    const float* Z = (const float*)(ws + WS_Z); float* outc = ldp<float>(lds, P_OUT) + (size_t)k.row0 * DM; bf16* XB = (bf16*)(ws + WS_XB);
    const float* g = ldp<const float>(lds, P_LNG) + layer * DM; const float* b = ldp<const float>(lds, P_LNB) + layer * DM;
    for (int m = x.gw; m < MC; m += x.NGW) ln_row(Z + (size_t)m * DM, g, b, outc + (size_t)m * DM, to_bf16 ? XB + (size_t)m * DM : nullptr, x.lane);
}
__device__ __forceinline__ void ph_even_mix(LAS unsigned char* lds, int c) {
    const Ctx x = mkctx(); const Chunk k = mkchunk(c); unsigned char* ws = ldp<unsigned char>(lds, P_WS);
#if NAIVE_EVEN
    naive_even((const bf16*)(ws + WS_H), (bf16*)(ws + WS_Y), k.T, ldp<const float>(lds, P_T5), ldp<const float>(lds, P_SINK), x.gtid, x.gstride);
#else
    const bf16* H = (const bf16*)(ws + WS_H); bf16* Y = (bf16*)(ws + WS_Y);
    even_tables(lds, ldp<const float>(lds, P_T5), x.tid);
    __syncthreads();
    LAS unsigned char* vl = lds + VT_OFF + x.wave * 4096;
    const float* sink = ldp<const float>(lds, P_SINK);
    for (int it = x.gw; it < (MC / 32) * 4; it += x.NGW) mixB_task(H, Y, k.T, lds, vl, it >> 2, it & 3, x.lane);
    for (int it = x.gw; it < (MC / 32) * 8; it += x.NGW) mixA_task(H, Y, k.T, sink, lds, vl, it >> 3, it & 7, x.lane);
    __syncthreads();
#endif
}
__device__ __forceinline__ void ph_odd_mix(LAS unsigned char* lds, int c) {
    const Ctx x = mkctx(); const Chunk k = mkchunk(c); unsigned char* ws = ldp<unsigned char>(lds, P_WS);
#if NAIVE_NA
    naive_na((const bf16*)(ws + WS_H), (bf16*)(ws + WS_Y), k.T, ldp<const float>(lds, P_RPB), x.gtid, x.gstride);
#else
    { const bf16* H = (const bf16*)(ws + WS_H); bf16* Y = (bf16*)(ws + WS_Y);
      odd_tables(lds, ldp<const float>(lds, P_RPB), x.tid);
      __syncthreads();
      LAS unsigned char* vl = lds + VT_OFF + x.wave * 4096;
      for (int it = x.gw; it < (MC / 32) * 8; it += x.NGW) mixC_task(H, Y, k.T, lds, vl, it >> 3, it & 7, x.lane);
      __syncthreads(); }
#endif
#if NAIVE_HGRN
    naive_hgrn((const bf16*)(ws + WS_H), (float*)(ws + WS_O), k.T, k.nseq, ldp<const float>(lds, P_LBD), lds, x.tid, x.bid, x.G);
#endif
}
#if !NAIVE_HGRN
template <int MODE> __device__ __forceinline__ void ph_hgrn(LAS unsigned char* lds, int c) {
    const Ctx x = mkctx(); const Chunk k = mkchunk(c); unsigned char* ws = ldp<unsigned char>(lds, P_WS);
    for (int task = x.bid; task < (MC / SEG) * 4; task += x.G)
        hgrn_seg_task<MODE>((const bf16*)(ws + WS_H), (float*)(ws + WS_O), (float*)(ws + WS_SLOC), (const float*)(ws + WS_SINIT), (float*)(ws + WS_DTOT), ldp<const float>(lds, P_LBD), k.T, lds, task, x.tid);
}
__device__ __forceinline__ void ph_hgrn_scan(LAS unsigned char* lds, int c) {
    const Ctx x = mkctx(); const Chunk k = mkchunk(c); unsigned char* ws = ldp<unsigned char>(lds, P_WS);
    hgrn_scan((const float*)(ws + WS_SLOC), (float*)(ws + WS_SINIT), (const float*)(ws + WS_DTOT), k.T, k.nseq, x.gtid, x.gstride);
}
#endif
__device__ __forceinline__ void ph_odd_combine(LAS unsigned char* lds) {
    const Ctx x = mkctx(); unsigned char* ws = ldp<unsigned char>(lds, P_WS);
    hgrn_combine((const bf16*)(ws + WS_H), (const float*)(ws + WS_O), (bf16*)(ws + WS_Y), ldp<const float>(lds, P_GN), x.gw, x.NGW, x.lane);
}

struct Args { const float* in[13]; float* out; unsigned char* ws; int pad0, pad1; };
__global__ void __launch_bounds__(NWAVES * 64, 2) mk_fwd(Args args) {
    extern __shared__ __attribute__((aligned(16))) unsigned char lds_raw[];
    LAS unsigned char* lds = (LAS unsigned char*)lds_raw;
    for (int u = threadIdx.x; u < (LDS_BYTES - LDSCTL_OFF) / 4; u += NWAVES * 64) ((LAS unsigned*)(lds + LDSCTL_OFF))[u] = 0u;
    __syncthreads();
    if (threadIdx.x == 0) { volatile LAS unsigned* PB = (volatile LAS unsigned*)(lds + PARAM_OFF);
#pragma unroll
        for (int i = 0; i < 13; ++i) { const unsigned long long p = (unsigned long long)args.in[i]; PB[2 * i] = (unsigned)p; PB[2 * i + 1] = (unsigned)(p >> 32); }
        { const unsigned long long p = (unsigned long long)args.out; PB[2 * P_OUT] = (unsigned)p; PB[2 * P_OUT + 1] = (unsigned)(p >> 32); }
        { const unsigned long long p = (unsigned long long)args.ws; PB[2 * P_WS] = (unsigned)p; PB[2 * P_WS + 1] = (unsigned)(p >> 32); } }
    __syncthreads();
    (void)xcd_barrier_post((unsigned*)(ldp<unsigned char>(lds, P_WS) + WS_CTL) + CW_BAR, (volatile LAS unsigned*)(lds + MISC_OFF) + 8);

    ph_weights(lds);
#ifndef PROBE_DUP
#define PROBE_DUP 0
#endif
#define RUNP(bit, ...) do { __VA_ARGS__; grid_bar(lds); if (PROBE_DUP & (1 << (bit))) { __VA_ARGS__; grid_bar(lds); } } while (0)
    for (int c = 0; c < NCH; ++c) {
        RUNP(0, ph_convert(lds, c));
        RUNP(1, ph_gemm_in<(int)WS_W1, EVEN_IN>(lds));
        RUNP(2, ph_even_mix(lds, c));
        RUNP(3, { const Chunk k = mkchunk(c); ph_gemm_out<(int)WS_W2, EVEN_OUT>(lds, chunk_x(lds, k)); });
        RUNP(4, ph_ln(lds, c, 0, true));
        RUNP(5, ph_gemm_in<(int)WS_W3, ODD_IN>(lds));
#if NAIVE_HGRN
        RUNP(6, ph_odd_mix(lds, c));
#else
        RUNP(6, ph_hgrn<0>(lds, c));
        RUNP(7, ph_odd_mix(lds, c); ph_hgrn_scan(lds, c));
        RUNP(8, ph_hgrn<1>(lds, c));
#endif
        RUNP(9, ph_odd_combine(lds));
        RUNP(10, { const Chunk k = mkchunk(c); ph_gemm_out<(int)WS_W4, ODD_OUT>(lds, ldp<const float>(lds, P_OUT) + (size_t)k.row0 * DM); });
        RUNP(11, ph_ln(lds, c, 1, false));
    }
}

extern "C" void kernel_launch(void* const* d_in, const int* in_sizes, int n_in, void* d_out, int out_size, void* d_ws, size_t ws_size, hipStream_t stream) {
    static int grid = 0;
    if (grid == 0) {
        if (n_in != 13 || out_size != NTOK * DM || ws_size < WS_END) { fprintf(stderr, "kernel_launch: unexpected shapes (n_in %d out %d ws %zu)\n", n_in, out_size, ws_size); grid = -1; return; }
        int dev = 0, cus = 0, per_cu = 0;
        (void)hipGetDevice(&dev); (void)hipDeviceGetAttribute(&cus, hipDeviceAttributeMultiprocessorCount, dev);
        (void)hipFuncSetAttribute((const void*)mk_fwd, hipFuncAttributeMaxDynamicSharedMemorySize, LDS_BYTES);
        (void)hipOccupancyMaxActiveBlocksPerMultiprocessor(&per_cu, (const void*)mk_fwd, NWAVES * 64, LDS_BYTES);
        (void)hipGetLastError();
        if (per_cu < 1) { fprintf(stderr, "kernel_launch: occupancy query says %d blocks per CU\n", per_cu); }
        grid = cus;
    }
    if (grid < 0) return;
    (void)hipMemsetAsync((char*)d_ws + WS_CTL, 0, CTL_ZERO_BYTES, stream);
    Args a{};
    for (int i = 0; i < 13; ++i) a.in[i] = (const float*)d_in[i];
    a.out = (float*)d_out; a.ws = (unsigned char*)d_ws;
    void* kargs[] = {&a};
    hipError_t e = hipLaunchCooperativeKernel((const void*)mk_fwd, dim3(grid), dim3(NWAVES * 64), kargs, LDS_BYTES, stream);
    if (e != hipSuccess) fprintf(stderr, "kernel_launch: cooperative launch failed: %s (grid %d)\n", hipGetErrorString(e), grid);
}
```
